# Optimizing an MI355X kernel written in HIP

```python
import math
import jax, jax.numpy as jnp
from jax import lax
import numpy as np

D_MODEL = 1024
BATCH = 16
SEQ = 256
DEPTH = 4
DEC_BATCH = 2
DEC_SEQ = 1024
PAST_LEN = 256

GRID_W = 64
BLOCK = 128
GROUP_W = D_MODEL // 4
A_HEADS = 4
A_HD = GROUP_W // A_HEADS
B_HEADS = 4
B_KV = 2
B_HD = GROUP_W // B_HEADS
B_GROUP = B_HEADS // B_KV
WINDOW = 128
C_HEADS = 4
C_HD = GROUP_W // C_HEADS
C_SUB = C_HD // 2
D_GROUPS = 4
D_GW = GROUP_W // D_GROUPS
POOL_SIZES = (2, 4, 8, 16)
PROJ_WIDTHS = (GROUP_W, GROUP_W,
               B_HEADS * B_HD, B_KV * B_HD, B_KV * B_HD,
               GROUP_W, GROUP_W, GROUP_W,
               GROUP_W)
P_COLS = sum(PROJ_WIDTHS)
PROJ_SPLITS = [int(s) for s in np.cumsum(PROJ_WIDTHS)[:-1]]
PK_HEADS = 8
N_KEYS = 128
N_EXPERTS = N_KEYS * N_KEYS
D_KEY = 128
PK_TOPK = 16
ROPE_BASE = 10000.0
ALPHA = (2 * DEPTH) ** 0.25
BETA = (8 * DEPTH) ** -0.25
LN_EPS = 1e-5

kernel_name = 'hybrid_flow_prefix_step'


def layer_norm(x):
    xf = x.astype(jnp.float32)
    mu = jnp.mean(xf, axis=-1, keepdims=True)
    var = jnp.mean(jnp.square(xf - mu), axis=-1, keepdims=True)
    return ((xf - mu) * lax.rsqrt(var + LN_EPS)).astype(x.dtype)


def rms_norm(x, g):
    xf = x.astype(jnp.float32)
    return (xf * lax.rsqrt(jnp.mean(xf * xf, axis=-1, keepdims=True) + LN_EPS)).astype(x.dtype) * g


def axial_rope(n_tok, dim):
    rows = n_tok // GRID_W
    row = jnp.repeat(jnp.arange(rows, dtype=jnp.float32), GRID_W)
    col = jnp.tile(jnp.arange(GRID_W, dtype=jnp.float32), rows)
    nf = dim // 4
    inv = ROPE_BASE ** (-jnp.arange(nf, dtype=jnp.float32) / nf)
    ar = row[:, None] * inv
    ac = col[:, None] * inv
    ang = jnp.concatenate([ar, ar, ac, ac], axis=-1)
    return jnp.cos(ang), jnp.sin(ang)


def apply_rope(x, rope):
    cos, sin = rope
    shp = (cos.shape[0],) + (1,) * (x.ndim - 3) + (cos.shape[1],)
    cos = cos.reshape(shp)
    sin = sin.reshape(shp)
    x1, x2, x3, x4 = jnp.split(x, 4, axis=-1)
    rot = jnp.concatenate([-x2, x1, -x4, x3], axis=-1)
    return (x * cos + rot * sin).astype(x.dtype)


def sweep_query_blocks(fn, q):
    b, t = q.shape[:2]
    qb = jnp.moveaxis(q.reshape((b, t // BLOCK, BLOCK) + q.shape[2:]), 1, 0)
    out = jnp.moveaxis(lax.map(fn, qb), 0, 1)
    return out.reshape((b, t) + out.shape[3:])


def softmax_with_sink(logits, sink):
    full = jnp.concatenate([logits, jnp.broadcast_to(sink, logits.shape[:-1] + (1,))], axis=-1)
    return jax.nn.softmax(full, axis=-1)[..., :-1]


def chunk_gating(u, v, w_s, b_s):
    b, s, h, d = v.shape
    vc = v.reshape(b, s // BLOCK, BLOCK, h, d)
    mixed = jnp.einsum('hpq,bnqhd->bnphd', w_s, vc) + b_s.T[None, None, :, :, None]
    return u * mixed.reshape(b, s, h, d)


def window_attn_context(q, k, v, sink):
    scale = B_HD ** -0.5
    sink = sink.astype(jnp.float32).reshape(B_KV, B_GROUP, 1, 1)

    def blk(qb):
        qg = qb.reshape(qb.shape[0], BLOCK, B_KV, B_GROUP, B_HD)
        s = jnp.einsum('bqkgd,bskd->bkgqs', qg, k).astype(jnp.float32) * scale
        p = softmax_with_sink(s, sink).astype(v.dtype)
        return jnp.einsum('bkgqs,bskd->bqkgd', p, v).reshape(qb.shape)

    return sweep_query_blocks(blk, q)


def window_attn_latent(q, k, v, k_ctx, v_ctx, sink):
    b, t = q.shape[:2]
    nb = t // BLOCK
    scale = B_HD ** -0.5
    qb = q.reshape(b, nb, BLOCK, B_KV, B_GROUP, B_HD)

    def band(x):
        xb = x.reshape(b, nb, BLOCK, B_KV, B_HD)
        xp = jnp.pad(xb, ((0, 0), (1, 1), (0, 0), (0, 0), (0, 0)))
        return jnp.concatenate([xp[:, :-2], xp[:, 1:-1], xp[:, 2:]], axis=2)

    kb, vb = band(k), band(v)
    qpos = jnp.arange(nb)[:, None] * BLOCK + jnp.arange(BLOCK)[None, :]
    kpos = (jnp.arange(nb)[:, None] - 1) * BLOCK + jnp.arange(3 * BLOCK)[None, :]
    rel = kpos[:, None, :] - qpos[:, :, None]
    valid = (jnp.abs(rel) <= WINDOW) & (kpos[:, None, :] >= 0) & (kpos[:, None, :] < t)
    s_loc = jnp.einsum('bnqkgd,bnskd->bnkgqs', qb, kb).astype(jnp.float32) * scale
    s_loc = jnp.where(valid[None, :, None, None], s_loc, -jnp.inf)
    s_ctx = jnp.einsum('bnqkgd,bskd->bnkgqs', qb, k_ctx).astype(jnp.float32) * scale
    p = softmax_with_sink(jnp.concatenate([s_loc, s_ctx], axis=-1),
                          sink.astype(jnp.float32).reshape(B_KV, B_GROUP, 1, 1)).astype(v.dtype)
    o = (jnp.einsum('bnkgqs,bnskd->bnqkgd', p[..., :3 * BLOCK], vb)
         + jnp.einsum('bnkgqs,bskd->bnqkgd', p[..., 3 * BLOCK:], v_ctx))
    return o.reshape(b, t, B_HEADS, B_HD)


def diff_attn(q, k, v, lam):
    scale = C_SUB ** -0.5

    def blk(qb):
        s = jnp.einsum('bqhjd,bshjd->bhjqs', qb, k).astype(jnp.float32) * scale
        p = jax.nn.softmax(s, axis=-1)
        w = p[:, :, 0] - lam * p[:, :, 1]
        return jnp.einsum('bhqs,bshd->bqhd', w.astype(v.dtype), v)

    return sweep_query_blocks(blk, q)


def multiscale_pool(z, w_pool, pool_scale):
    b, s, _ = z.shape
    zf = z.astype(jnp.float32)
    cs = jnp.concatenate([jnp.zeros((b, 1, GROUP_W), jnp.float32), jnp.cumsum(zf, axis=1)], axis=1)
    t = jnp.arange(s)
    outs = []
    for g, w in enumerate(POOL_SIZES):
        lo = jnp.clip(t - w // 2, 0, s)
        hi = jnp.clip(t + w // 2, 0, s)
        c0, c1 = g * D_GW, (g + 1) * D_GW
        mean = (cs[:, hi, c0:c1] - cs[:, lo, c0:c1]) / (hi - lo).astype(jnp.float32)[None, :, None]
        outs.append(mean - zf[:, :, c0:c1])
    pooled = jnp.stack(outs, axis=2)
    y = jnp.einsum('bsgc,gcd->bsgd', pooled, w_pool).reshape(b, s, GROUP_W)
    return (y * pool_scale).astype(z.dtype)


def peer(x, w_q, sub_keys, u_tab, v_tab):
    b, s, d = x.shape
    xt = x.reshape(-1, d)
    nt = xt.shape[0]
    q = (xt @ w_q).reshape(nt, PK_HEADS, 2, D_KEY // 2)
    sc = jnp.einsum('thjd,jnd->thjn', q, sub_keys).astype(jnp.float32)
    sv, si = lax.top_k(sc, PK_TOPK)
    cand = sv[:, :, 0, :, None] + sv[:, :, 1, None, :]
    cv, ci = lax.top_k(cand.reshape(nt, PK_HEADS, PK_TOPK * PK_TOPK), PK_TOPK)
    i1 = jnp.take_along_axis(si[:, :, 0], ci // PK_TOPK, axis=-1)
    i2 = jnp.take_along_axis(si[:, :, 1], ci % PK_TOPK, axis=-1)
    idx = i1 * N_KEYS + i2
    gate = jax.nn.softmax(cv, axis=-1)

    def blk(args):
        xb, ib, gb = args
        ue = jnp.take(u_tab, ib, axis=0)
        act = jax.nn.gelu(jnp.einsum('thkd,td->thk', ue, xb).astype(jnp.float32))
        ve = jnp.take(v_tab, ib, axis=0)
        return jnp.einsum('thk,thkd->td', (gb * act).astype(xb.dtype), ve)

    nblk = nt // BLOCK
    out = lax.map(blk, (xt.reshape(nblk, BLOCK, d),
                        idx.reshape(nblk, BLOCK, PK_HEADS, PK_TOPK),
                        gate.reshape(nblk, BLOCK, PK_HEADS, PK_TOPK)))
    return out.reshape(b, s, d)


def trunk_layer(x, mod, w_in, w_out, chunk_w, chunk_b, sink, lam, subln_g, lam_init,
                pool_w, pool_scale, ln_g, ln_b, peer_wq, peer_keys, peer_u, peer_v, latent=None):
    b, s, _ = x.shape
    sh1, sc1, g1, sh2, sc2, g2 = jnp.split(mod, 6, axis=-1)
    h = layer_norm(x) * (1 + sc1) + sh1
    a_u, a_v, bq, bk, bv, cq, ck, cv, dz = jnp.split(h @ w_in, PROJ_SPLITS, axis=-1)
    u = jax.nn.gelu(a_u).reshape(b, s, A_HEADS, A_HD)
    v = jax.nn.gelu(a_v).reshape(b, s, A_HEADS, A_HD)
    o_a = chunk_gating(u, v, chunk_w, chunk_b).reshape(b, s, GROUP_W)
    bq = bq.reshape(b, s, B_HEADS, B_HD)
    bk = bk.reshape(b, s, B_KV, B_HD)
    bv = bv.reshape(b, s, B_KV, B_HD)
    cq = cq.reshape(b, s, C_HEADS, 2, C_SUB)
    ck = ck.reshape(b, s, C_HEADS, 2, C_SUB)
    cv = cv.reshape(b, s, C_HEADS, C_HD)
    if latent is None:
        o_b = window_attn_context(bq, bk, bv, sink)
        o_c = diff_attn(cq, ck, cv, lam)
    else:
        rope_b, rope_c, kb_ctx, vb_ctx, kc_ctx, vc_ctx = latent
        o_b = window_attn_latent(apply_rope(bq, rope_b), apply_rope(bk, rope_b), bv, kb_ctx, vb_ctx, sink)
        o_c = diff_attn(apply_rope(cq, rope_c),
                        jnp.concatenate([kc_ctx, apply_rope(ck, rope_c)], axis=1),
                        jnp.concatenate([vc_ctx, cv], axis=1), lam)
    o_c = rms_norm(o_c, subln_g) * (1.0 - lam_init)
    o_d = multiscale_pool(dz, pool_w, pool_scale)
    o = jnp.concatenate([o_a, o_b.reshape(b, s, GROUP_W), o_c.reshape(b, s, GROUP_W), o_d], axis=-1) @ w_out
    x = layer_norm(ALPHA * x + g1 * o) * ln_g[0] + ln_b[0]
    h = layer_norm(x) * (1 + sc2) + sh2
    f = peer(h, peer_wq, peer_keys, peer_u, peer_v)
    x = layer_norm(ALPHA * x + g2 * f) * ln_g[1] + ln_b[1]
    return x, (bk, bv, ck, cv)


def setup_inputs(seed: int = 0) -> dict:
    key = jax.random.key(seed)
    ks = jax.random.split(key, 26)

    def nrm(k, shape, s):
        return jax.random.normal(k, shape, jnp.float32) * s

    return {
        'x_prompt': nrm(ks[0], (BATCH, SEQ, D_MODEL), 1.0),
        'x_sample': nrm(ks[1], (DEC_BATCH, DEC_SEQ, D_MODEL), 1.0),
        'c': nrm(ks[2], (DEC_BATCH, D_MODEL), 1.0),
        'cache_win_k': nrm(ks[3], (DEC_BATCH, DEPTH, PAST_LEN, B_KV, B_HD), 1.0),
        'cache_win_v': nrm(ks[4], (DEC_BATCH, DEPTH, PAST_LEN, B_KV, B_HD), 1.0),
        'cache_diff_k': nrm(ks[5], (DEC_BATCH, DEPTH, PAST_LEN, C_HEADS, 2, C_SUB), 1.0),
        'cache_diff_v': nrm(ks[6], (DEC_BATCH, DEPTH, PAST_LEN, C_HEADS, C_HD), 1.0),
        'c_ctx': nrm(ks[7], (D_MODEL,), 1.0),
        'w_mod': nrm(ks[8], (DEPTH, D_MODEL, 6 * D_MODEL), 0.5 * D_MODEL ** -0.5),
        'b_mod': nrm(ks[9], (DEPTH, 6 * D_MODEL), 0.01),
        'w_in': nrm(ks[10], (DEPTH, D_MODEL, P_COLS), D_MODEL ** -0.5),
        'w_out': nrm(ks[11], (DEPTH, D_MODEL, D_MODEL), BETA * D_MODEL ** -0.5),
        'chunk_w': nrm(ks[12], (DEPTH, A_HEADS, BLOCK, BLOCK), BLOCK ** -0.5),
        'chunk_b': 1.0 + nrm(ks[13], (DEPTH, A_HEADS, BLOCK), 0.01),
        'win_sink': nrm(ks[14], (DEPTH, B_HEADS), 0.5),
        'diff_lam_q': nrm(ks[15], (DEPTH, 2, C_SUB), 0.1),
        'diff_lam_k': nrm(ks[16], (DEPTH, 2, C_SUB), 0.1),
        'diff_subln_g': 1.0 + nrm(ks[17], (DEPTH, C_HD), 0.02),
        'pool_w': nrm(ks[18], (DEPTH, D_GROUPS, D_GW, D_GW), D_GW ** -0.5),
        'pool_scale': 1.0 + nrm(ks[19], (DEPTH, GROUP_W), 0.02),
        'ln_g': 1.0 + nrm(ks[20], (DEPTH, 2, D_MODEL), 0.02),
        'ln_b': nrm(ks[21], (DEPTH, 2, D_MODEL), 0.01),
        'peer_wq': nrm(ks[22], (DEPTH, D_MODEL, PK_HEADS * D_KEY), D_MODEL ** -0.5),
        'peer_keys': nrm(ks[23], (DEPTH, 2, N_KEYS, D_KEY // 2), (D_KEY // 2) ** -0.5),
        'peer_u': nrm(ks[24], (DEPTH, N_EXPERTS, D_MODEL), D_MODEL ** -0.5),
        'peer_v': nrm(ks[25], (DEPTH, N_EXPERTS, D_MODEL), BETA),
    }


def reference(x_prompt, x_sample, c, cache_win_k, cache_win_v, cache_diff_k, cache_diff_v, c_ctx,
              w_mod, b_mod, w_in, w_out, chunk_w, chunk_b, win_sink, diff_lam_q, diff_lam_k,
              diff_subln_g, pool_w, pool_scale, ln_g, ln_b, peer_wq, peer_keys, peer_u, peer_v):
    n_lat = x_sample.shape[1]
    rope_b = axial_rope(n_lat, B_HD)
    rope_c = axial_rope(n_lat, C_SUB)
    y_p, y_s = x_prompt, x_sample
    kbs, vbs, kcs, vcs = [], [], [], []
    for l in range(DEPTH):
        lam_init = 0.8 - 0.6 * math.exp(-0.3 * l)
        lam = (jnp.exp(jnp.sum(diff_lam_q[l, 0] * diff_lam_k[l, 0]).astype(jnp.float32))
               - jnp.exp(jnp.sum(diff_lam_q[l, 1] * diff_lam_k[l, 1]).astype(jnp.float32)) + lam_init)
        shared = (w_in[l], w_out[l], chunk_w[l], chunk_b[l], win_sink[l], lam, diff_subln_g[l], lam_init,
                  pool_w[l], pool_scale[l], ln_g[l], ln_b[l], peer_wq[l], peer_keys[l], peer_u[l], peer_v[l])
        mod_ctx = (jax.nn.silu(c_ctx) @ w_mod[l] + b_mod[l])[None, None, :]
        y_p, (kb, vb, kc, vc) = trunk_layer(y_p, mod_ctx, *shared)
        kbs.append(kb)
        vbs.append(vb)
        kcs.append(kc)
        vcs.append(vc)
        mod_lat = (jax.nn.silu(c) @ w_mod[l] + b_mod[l])[:, None, :]
        y_s, _ = trunk_layer(y_s, mod_lat, *shared,
                             latent=(rope_b, rope_c, cache_win_k[:, l], cache_win_v[:, l],
                                     cache_diff_k[:, l], cache_diff_v[:, l]))
    new_win_k = jnp.stack(kbs, axis=1)
    new_win_v = jnp.stack(vbs, axis=1)
    new_diff_k = jnp.stack(kcs, axis=1)
    new_diff_v = jnp.stack(vcs, axis=1)
    return (y_p, y_sample_out := y_s, new_win_k, new_win_v, new_diff_k, new_diff_v)
```

```cpp
#include <hip/hip_runtime.h>
#include <hip/hip_cooperative_groups.h>
#include <cstdio>
namespace cg = cooperative_groups;

#define DI __device__ __forceinline__
typedef short bf16x8 __attribute__((ext_vector_type(8)));
typedef short s16x4 __attribute__((ext_vector_type(4)));
typedef float f32x16 __attribute__((ext_vector_type(16)));
typedef unsigned short bf16_t;
typedef unsigned u32x4 __attribute__((ext_vector_type(4)));
#define MFMA(a, b, c) __builtin_amdgcn_mfma_f32_32x32x16_bf16((a), (b), (c), 0, 0, 0)

constexpr int DM = 1024, TCTX = 4096, TLAT = 2048, NT = 6144, PC = 2048, DEPTH = 4;
constexpr int NEXP = 16384;
constexpr float ALPHA = 1.681792830507429f;
constexpr float LN_EPS = 1e-5f;
constexpr int NTHR = 256;

constexpr size_t OUT_Y = 0;
constexpr size_t OUT_WK = 6291456, OUT_WV = 8388608, OUT_DK = 10485760, OUT_DV = 14680064;

constexpr size_t SZ_WINT = (size_t)DEPTH * PC * DM * 2;
constexpr size_t SZ_WSQ = (size_t)DEPTH * DM * DM * 2;
constexpr size_t SZ_TAB = (size_t)DEPTH * NEXP * DM * 2;
constexpr size_t OFF_WINT = 0;
constexpr size_t OFF_WOUTT = OFF_WINT + SZ_WINT;
constexpr size_t OFF_WQT = OFF_WOUTT + SZ_WSQ;
constexpr size_t OFF_UB = OFF_WQT + SZ_WSQ;
constexpr size_t OFF_VB = OFF_UB + SZ_TAB;
constexpr size_t OFF_X = OFF_VB + SZ_TAB;
constexpr size_t OFF_H = OFF_X + (size_t)NT * DM * 4;
constexpr size_t OFF_P = OFF_H + (size_t)NT * DM * 2;
constexpr size_t OFF_O = OFF_P + (size_t)NT * PC * 2;
constexpr size_t OFF_Q = OFF_O + (size_t)NT * DM * 2;
constexpr size_t OFF_MOD = OFF_Q + (size_t)NT * DM * 4;
constexpr size_t OFF_MODP = OFF_MOD + (size_t)DEPTH * 3 * 6144 * 4;
constexpr size_t OFF_ROPEB = OFF_MODP + (size_t)DEPTH * 16 * 3 * 6144 * 4;
constexpr size_t OFF_ROPEC = OFF_ROPEB + (size_t)1024 * 64 * 2 * 4;
constexpr size_t OFF_LAM = OFF_ROPEC + (size_t)1024 * 32 * 2 * 4;
constexpr size_t OFF_CTR = OFF_LAM + 256;
constexpr size_t OFF_CWKB = OFF_CTR + 1024;
constexpr size_t OFF_CWVB = OFF_CWKB + (size_t)2 * 4 * 256 * 128 * 2;
constexpr size_t OFF_CDKB = OFF_CWVB + (size_t)2 * 4 * 256 * 128 * 2;
constexpr size_t OFF_CDVB = OFF_CDKB + (size_t)2 * 4 * 256 * 256 * 2;
constexpr size_t OFF_USC = OFF_CDVB + (size_t)2 * 4 * 256 * 256 * 2;
constexpr size_t OFF_VSC = OFF_USC + (size_t)DEPTH * NEXP * 4;
constexpr size_t OFF_KEYB = OFF_VSC + (size_t)DEPTH * NEXP * 4;
constexpr size_t OFF_BAR = OFF_KEYB + (size_t)DEPTH * 2 * 128 * 64 * 2; constexpr size_t OFF_BAR_UNUSED = OFF_CDVB + (size_t)2 * 4 * 256 * 256 * 2;
constexpr size_t OFF_X2 = OFF_BAR + 4 * 16384;
constexpr size_t OFF_H2 = OFF_X2 + (size_t)NT * DM * 4;
constexpr size_t OFF_QCTR = OFF_H2 + (size_t)NT * DM * 2;
constexpr int REP_P0 = 1, REP_G1 = 1, REP_MIX = 1, REP_G2 = 1, REP_LN1 = 1, REP_G3 = 1, REP_PEER = 1;
constexpr int SLOT_OFF = 78000;

struct Params {
  const float *x_prompt, *x_sample, *c, *cwk, *cwv, *cdk, *cdv, *c_ctx, *w_mod, *b_mod, *w_in, *w_out, *chunk_w, *chunk_b,
      *win_sink, *lam_q, *lam_k, *subln_g, *pool_w, *pool_scale, *ln_g, *ln_b, *peer_wq, *peer_keys, *peer_u, *peer_v;
  float* out;
  char* ws;
};

typedef __bf16 bf2v_t __attribute__((ext_vector_type(2)));
typedef float f2v_t __attribute__((ext_vector_type(2)));
DI unsigned pk2(float a, float b) { f2v_t v = {a, b}; return __builtin_bit_cast(unsigned, __builtin_convertvector(v, bf2v_t)); }
DI unsigned short f2bf(float x) { return (unsigned short)(pk2(x, 0.f) & 0xffffu); }
DI float bflo(unsigned u) { return __uint_as_float(u << 16); }
DI float bfhi(unsigned u) { return __uint_as_float(u & 0xffff0000u); }
DI float gelu_t(float x) { return x / (1.f + __expf(-1.5957691216057308f * (x + 0.044715f * x * x * x))); }
DI float wave_sum(float v) {
#pragma unroll
  for (int o = 32; o; o >>= 1) v += __shfl_xor(v, o);
  return v;
}
typedef __bf16 bf2_t __attribute__((ext_vector_type(2)));
DI float dot2bf(unsigned a, unsigned b, float c) { return __builtin_amdgcn_fdot2_f32_bf16(__builtin_bit_cast(bf2_t, a), __builtin_bit_cast(bf2_t, b), c, false); }
typedef float f32x4nt_t __attribute__((ext_vector_type(4)));
DI float4 ld_nt4(const float* p) { const f32x4nt_t t = __builtin_nontemporal_load((const f32x4nt_t*)p); return make_float4(t[0], t[1], t[2], t[3]); }
DI int opaque_tid() { int t = threadIdx.x; asm volatile("" : "+v"(t)); return t; }
struct Grp { int g, lb, GB, j, lq, QB; };
DI Grp my_grp() { Grp r; r.GB = (int)gridDim.x >> 1; r.g = (int)blockIdx.x & 1; r.lb = (int)blockIdx.x >> 1; r.j = r.lb & 3; r.lq = r.lb >> 2; r.QB = r.GB >> 2; return r; }
DI int mtile_g(int g, int mt) { return mt < 16 ? g * 16 + mt : 32 + g * 8 + (mt - 16); }
DI int tok_g(int g, int u) { return u < 2048 ? g * 2048 + u : TCTX + g * 1024 + (u - 2048); }
constexpr int GTOK = 3072;
constexpr int QTOK = 768;
constexpr bool SPLIT_OFFSET = true;
DI int next_tile_q(const Grp& gr, int* ctrq, char* smem, bool& first) {
  int* slot = (int*)(smem + SLOT_OFF);
  if (first) { first = false; return gr.lq; }
  __syncthreads();
  if (threadIdx.x == 0) *slot = gr.QB + atomicAdd(ctrq, 1);
  __syncthreads();
  return *slot;
}
DI int next_item(const Grp& gr, int* ctr, char* smem, bool& first, int nshard) {
  int* slot = (int*)(smem + SLOT_OFF);
  if (first) { first = false; return gr.lb; }
  __syncthreads();
  if (threadIdx.x == 0) {
    const int q = (nshard == 8) ? (gr.lb & 7) : 0;
    *slot = gr.GB + q + nshard * atomicAdd(ctr + q * 64, 1);
  }
  __syncthreads();
  return *slot;
}
DI int crow(int reg, int h) { return (reg & 3) + 8 * (reg >> 2) + 4 * h; }
DI uint4 pack8(const float* v) {
  uint4 r;
  r.x = pk2(v[0], v[1]); r.y = pk2(v[2], v[3]); r.z = pk2(v[4], v[5]); r.w = pk2(v[6], v[7]);
  return r;
}
DI bf16x8 as_bf16x8(uint4 u) { return __builtin_bit_cast(bf16x8, u); }

DI void load_row(const float* p, int lane, float (&v)[16]) {
#pragma unroll
  for (int c = 0; c < 2; ++c) {
    float4 a = *(const float4*)(p + c * 512 + lane * 8);
    float4 b = *(const float4*)(p + c * 512 + lane * 8 + 4);
    v[c * 8 + 0] = a.x; v[c * 8 + 1] = a.y; v[c * 8 + 2] = a.z; v[c * 8 + 3] = a.w;
    v[c * 8 + 4] = b.x; v[c * 8 + 5] = b.y; v[c * 8 + 6] = b.z; v[c * 8 + 7] = b.w;
  }
}
DI void store_row(float* p, int lane, const float (&v)[16]) {
#pragma unroll
  for (int c = 0; c < 2; ++c) {
    *(float4*)(p + c * 512 + lane * 8) = make_float4(v[c * 8 + 0], v[c * 8 + 1], v[c * 8 + 2], v[c * 8 + 3]);
    *(float4*)(p + c * 512 + lane * 8 + 4) = make_float4(v[c * 8 + 4], v[c * 8 + 5], v[c * 8 + 6], v[c * 8 + 7]);
  }
}
DI void store_row_bf(bf16_t* p, int lane, const float (&v)[16]) {
#pragma unroll
  for (int c = 0; c < 2; ++c) *(uint4*)(p + c * 512 + lane * 8) = pack8(&v[c * 8]);
}
DI void load_row16(const float* p, int lane, float (&v)[16]) {
#pragma unroll
  for (int j = 0; j < 4; ++j) {
    float4 a = *(const float4*)(p + j * 256 + lane * 4);
    v[4 * j] = a.x; v[4 * j + 1] = a.y; v[4 * j + 2] = a.z; v[4 * j + 3] = a.w;
  }
}
DI void store_row16(float* p, int lane, const float (&v)[16]) {
#pragma unroll
  for (int j = 0; j < 4; ++j) *(float4*)(p + j * 256 + lane * 4) = make_float4(v[4 * j], v[4 * j + 1], v[4 * j + 2], v[4 * j + 3]);
}
DI void ln_stats(const float (&v)[16], float& mu, float& rstd) {
  float s = 0.f;
#pragma unroll
  for (int i = 0; i < 16; ++i) s += v[i];
  s = wave_sum(s);
  mu = s * (1.f / 1024.f);
  float q = 0.f;
#pragma unroll
  for (int i = 0; i < 16; ++i) { float d = v[i] - mu; q += d * d; }
  q = wave_sum(q);
  rstd = rsqrtf(q * (1.f / 1024.f) + LN_EPS);
}
DI int tok_grp(int t) { return t < TCTX ? 0 : 1 + ((t - TCTX) >> 10); }
DI void ln_mod_to_bf(const float (&v)[16], const float* modv, int shoff, bf16_t* dst, int lane) {
  float mu, rstd;
  ln_stats(v, mu, rstd);
  float sh[16], sc[16], h[16];
  load_row(modv + shoff, lane, sh);
  load_row(modv + shoff + 1024, lane, sc);
#pragma unroll
  for (int i = 0; i < 16; ++i) h[i] = (v[i] - mu) * rstd * (1.f + sc[i]) + sh[i];
  store_row_bf(dst, lane, h);
}

DI void convert_tables(const Params& p, int r0, int r1, int gw, int nw) {
  char* ws = p.ws;
  const int lane = opaque_tid() & 63;
  const int nrow = r1 - r0;
  for (int bi = gw * 4; bi < 2 * nrow; bi += nw * 4) {
    const int tb = bi >= nrow ? 1 : 0;
    const int row = r0 + (bi - tb * nrow);
    const float* src = (tb ? p.peer_v : p.peer_u) + ((size_t)row << 10) + lane * 4;
    unsigned char* dst = (unsigned char*)(ws + OFF_UB) + ((size_t)row << 11) + tb * 1024 + lane * 16;
    float* sc = (float*)(ws + (tb ? OFF_VSC : OFF_USC)) + row;
    float4 x[4][4];
#pragma unroll
    for (int rr = 0; rr < 4; ++rr)
#pragma unroll
      for (int j = 0; j < 4; ++j) x[rr][j] = ld_nt4(src + (size_t)rr * 1024 + j * 256);
#pragma unroll
    for (int rr = 0; rr < 4; ++rr) {
      float am = 0.f;
#pragma unroll
      for (int j = 0; j < 4; ++j) am = fmaxf(am, fmaxf(fmaxf(fabsf(x[rr][j].x), fabsf(x[rr][j].y)), fmaxf(fabsf(x[rr][j].z), fabsf(x[rr][j].w))));
#pragma unroll
      for (int o = 32; o; o >>= 1) am = fmaxf(am, __shfl_xor(am, o));
      const float scale = am > 0.f ? 256.f / am : 1.f;
      u32x4 q;
#pragma unroll
      for (int j = 0; j < 4; ++j) {
        int w = __builtin_amdgcn_cvt_pk_fp8_f32(x[rr][j].x * scale, x[rr][j].y * scale, 0, false);
        w = __builtin_amdgcn_cvt_pk_fp8_f32(x[rr][j].z * scale, x[rr][j].w * scale, w, true);
        q[j] = (unsigned)w;
      }
      *(u32x4*)(dst + (size_t)rr * 2048) = q;
      if (lane == 0) sc[rr] = am > 0.f ? am * (1.f / 256.f) : 1.f;
    }
  }
}

DI void transpose_tile(const float* src, bf16_t* dst, int K, int N, int k0, int n0, float* tile  ) {
  const int tid = threadIdx.x;
#pragma unroll
  for (int i = 0; i < 4; ++i) {
    const int row = i * 16 + (tid >> 4), c4 = (tid & 15) * 4;
    const float4 v = ld_nt4(src + (size_t)(k0 + row) * N + n0 + c4);
    tile[row * 65 + c4] = v.x; tile[row * 65 + c4 + 1] = v.y; tile[row * 65 + c4 + 2] = v.z; tile[row * 65 + c4 + 3] = v.w;
  }
  __syncthreads();
#pragma unroll
  for (int i = 0; i < 2; ++i) {
    const int nrow = i * 32 + (tid >> 3), kc = (tid & 7) * 8;
    float f[8];
#pragma unroll
    for (int k = 0; k < 8; ++k) f[k] = tile[(kc + k) * 65 + nrow];
    *(uint4*)(dst + (size_t)(n0 + nrow) * K + k0 + kc) = pack8(f);
  }
  __syncthreads();
}

DI void phase0(const Params& p, char* smem) {
  const int tid = threadIdx.x;
  const int gthreads = gridDim.x * NTHR;
  const int gtid = blockIdx.x * NTHR + tid;
  char* ws = p.ws;
  for (int it = blockIdx.x; it < DEPTH * 1024; it += gridDim.x) {
    int l = it >> 10, r = it & 1023;
    if (r < 512) {
      int kt = r >> 5, nt = r & 31;
      transpose_tile(p.w_in + (size_t)l * DM * PC, (bf16_t*)(ws + OFF_WINT) + (size_t)l * PC * DM, DM, PC, kt * 64, nt * 64, (float*)smem);
    } else if (r < 768) {
      int q = r - 512, kt = q >> 4, nt = q & 15;
      transpose_tile(p.w_out + (size_t)l * DM * DM, (bf16_t*)(ws + OFF_WOUTT) + (size_t)l * DM * DM, DM, DM, kt * 64, nt * 64, (float*)smem);
    } else {
      int q = r - 768, kt = q >> 4, nt = q & 15;
      transpose_tile(p.peer_wq + (size_t)l * DM * DM, (bf16_t*)(ws + OFF_WQT) + (size_t)l * DM * DM, DM, DM, kt * 64, nt * 64, (float*)smem);
    }
  }
  {
    float* sv = (float*)smem;
    float* red = sv + 3 * 1024;
    for (int i = tid; i < 3 * 1024; i += NTHR) {
      int v = i >> 10, k = i & 1023;
      float x = (v == 0) ? p.c_ctx[k] : p.c[(v - 1) * 1024 + k];
      sv[i] = x / (1.f + __expf(-x));
    }
    __syncthreads();
    const int wave = tid >> 6, lane = tid & 63;
    float* modp = (float*)(ws + OFF_MODP);
    for (int it = blockIdx.x; it < DEPTH * 24 * 16; it += gridDim.x) {
      int l = it / 384, r = it % 384, nb = r >> 4, ks = r & 15;
      int kbase = ks * 64 + wave * 16;
      const float* wp = p.w_mod + ((size_t)l * DM + kbase) * 6144 + nb * 256 + lane * 4;
      float4 w[16];
#pragma unroll
      for (int k = 0; k < 16; ++k) w[k] = ld_nt4(wp + (size_t)k * 6144);
      float a[3][4];
#pragma unroll
      for (int v = 0; v < 3; ++v) { a[v][0] = a[v][1] = a[v][2] = a[v][3] = 0.f; }
#pragma unroll
      for (int k = 0; k < 16; ++k) {
#pragma unroll
        for (int v = 0; v < 3; ++v) {
          float s = sv[v * 1024 + kbase + k];
          a[v][0] += s * w[k].x; a[v][1] += s * w[k].y; a[v][2] += s * w[k].z; a[v][3] += s * w[k].w;
        }
      }
#pragma unroll
      for (int v = 0; v < 3; ++v)
        *(float4*)&red[(wave * 3 + v) * 256 + lane * 4] = make_float4(a[v][0], a[v][1], a[v][2], a[v][3]);
      __syncthreads();
      for (int i = tid; i < 768; i += NTHR) {
        int v = i >> 8, cidx = i & 255;
        float s = red[(0 * 3 + v) * 256 + cidx] + red[(1 * 3 + v) * 256 + cidx] + red[(2 * 3 + v) * 256 + cidx] + red[(3 * 3 + v) * 256 + cidx];
        modp[(((size_t)l * 16 + ks) * 3 + v) * 6144 + nb * 256 + cidx] = s;
      }
      __syncthreads();
    }
  }
  convert_tables(p, 0, (SPLIT_OFFSET ? 2 : 4) * NEXP, blockIdx.x * 4 + (tid >> 6), gridDim.x * 4);
  {
    const int n1 = 2 * 4 * 256 * 128 / 8, n2 = 2 * 4 * 256 * 256 / 8;
    for (int i = gtid; i < 2 * n1 + 2 * n2; i += gthreads) {
      const float* src; uint4* dst; int j;
      if (i < n1) { src = p.cwk; dst = (uint4*)(ws + OFF_CWKB); j = i; }
      else if (i < 2 * n1) { src = p.cwv; dst = (uint4*)(ws + OFF_CWVB); j = i - n1; }
      else if (i < 2 * n1 + n2) { src = p.cdk; dst = (uint4*)(ws + OFF_CDKB); j = i - 2 * n1; }
      else { src = p.cdv; dst = (uint4*)(ws + OFF_CDVB); j = i - 2 * n1 - n2; }
      float4 a = ((const float4*)src)[2 * j], bb = ((const float4*)src)[2 * j + 1];
      uint4 rr; rr.x = pk2(a.x, a.y); rr.y = pk2(a.z, a.w); rr.z = pk2(bb.x, bb.y); rr.w = pk2(bb.z, bb.w);
      dst[j] = rr;
    }
  }
  for (int i = gtid; i < DEPTH * 2 * 128 * 64 / 8; i += gthreads) {
    float4 a = ((const float4*)p.peer_keys)[2 * i], bb = ((const float4*)p.peer_keys)[2 * i + 1];
    uint4 rr; rr.x = pk2(a.x, a.y); rr.y = pk2(a.z, a.w); rr.z = pk2(bb.x, bb.y); rr.w = pk2(bb.z, bb.w);
    ((uint4*)(ws + OFF_KEYB))[i] = rr;
  }
  {
    float* rb = (float*)(ws + OFF_ROPEB);
    float* rc = (float*)(ws + OFF_ROPEC);
    for (int i = gtid; i < 1024 * 64; i += gthreads) {
      int pos = i >> 6, d = i & 63;
      float pv = (d < 32) ? (float)(pos >> 6) : (float)(pos & 63);
      float inv = powf(10000.f, -(float)(d & 15) / 16.f);
      float ang = pv * inv;
      rb[i] = cosf(ang);
      rb[1024 * 64 + i] = sinf(ang);
    }
    for (int i = gtid; i < 1024 * 32; i += gthreads) {
      int pos = i >> 5, d = i & 31;
      float pv = (d < 16) ? (float)(pos >> 6) : (float)(pos & 63);
      float inv = powf(10000.f, -(float)(d & 7) / 8.f);
      float ang = pv * inv;
      rc[i] = cosf(ang);
      rc[1024 * 32 + i] = sinf(ang);
    }
  }
  if (blockIdx.x == 0) { for (int i = tid; i < 2 * 32 * 512; i += NTHR) ((int*)(ws + OFF_QCTR))[i] = 0; }
  if (blockIdx.x == 0 && tid < DEPTH) {
    int l = tid;
    float s0 = 0.f, s1 = 0.f;
    for (int i = 0; i < 32; ++i) {
      s0 += p.lam_q[l * 64 + i] * p.lam_k[l * 64 + i];
      s1 += p.lam_q[l * 64 + 32 + i] * p.lam_k[l * 64 + 32 + i];
    }
    float lam_init = 0.8f - 0.6f * expf(-0.3f * (float)l);
    ((float*)(ws + OFF_LAM))[l] = expf(s0) - expf(s1) + lam_init;
    ((float*)(ws + OFF_LAM))[4 + l] = lam_init;
  }
}

DI void phase_modreduce(const Params& p) {
  const int gthreads = gridDim.x * NTHR;
  const int gtid = blockIdx.x * NTHR + threadIdx.x;
  const float* modp = (const float*)(p.ws + OFF_MODP);
  float* mod = (float*)(p.ws + OFF_MOD);
  for (int i = gtid; i < DEPTH * 3 * 6144; i += gthreads) {
    int l = i / (3 * 6144), r = i % (3 * 6144), n = r % 6144;
    float s = p.b_mod[l * 6144 + n];
#pragma unroll
    for (int ks = 0; ks < 16; ++ks) s += modp[((size_t)l * 16 + ks) * 3 * 6144 + r];
    mod[i] = s;
  }
}

DI void phase_ln0(const Params& p) {
  const int lane = threadIdx.x & 63;
  const int gw = blockIdx.x * 4 + (threadIdx.x >> 6), nw = gridDim.x * 4;
  float* X = (float*)(p.ws + OFF_X);
  bf16_t* H = (bf16_t*)(p.ws + OFF_H);
  const float* mod = (const float*)(p.ws + OFF_MOD);
  for (int t = gw; t < NT; t += nw) {
    const float* src = t < TCTX ? p.x_prompt + (size_t)t * DM : p.x_sample + (size_t)(t - TCTX) * DM;
    float v[16];
    load_row(src, lane, v);
    store_row(X + (size_t)t * DM, lane, v);
    ln_mod_to_bf(v, mod + (size_t)(0 * 3 + tok_grp(t)) * 6144, 0, H + (size_t)t * DM, lane);
  }
}

DI void phase_ln1(const Grp& gr, const Params& p, int l, bool dry) {
  const int tid = opaque_tid();
  const int lane = tid & 63;
  const int gw = gr.lq * 4 + (tid >> 6), nw = gr.QB * 4;
  const float* X = (const float*)(p.ws + OFF_X);
  float* Xo = (float*)(p.ws + (dry ? OFF_X2 : OFF_X));
  bf16_t* H = (bf16_t*)(p.ws + (dry ? OFF_H2 : OFF_H));
  const float* mod = (const float*)(p.ws + OFF_MOD);
  for (int uq = gw; uq < QTOK; uq += nw) {
    const int t = tok_g(gr.g, gr.j * QTOK + uq);
    float v[16], g[16], b[16];
    load_row(X + (size_t)t * DM, lane, v);
    load_row(p.ln_g + (size_t)(l * 2 + 0) * DM, lane, g);
    load_row(p.ln_b + (size_t)(l * 2 + 0) * DM, lane, b);
    float mu, rstd;
    ln_stats(v, mu, rstd);
#pragma unroll
    for (int i = 0; i < 16; ++i) v[i] = (v[i] - mu) * rstd * g[i] + b[i];
    store_row(Xo + (size_t)t * DM, lane, v);
    ln_mod_to_bf(v, mod + (size_t)(l * 3 + tok_grp(t)) * 6144, 3072, H + (size_t)t * DM, lane);
  }
}

constexpr int GSTR = 72;
template <class Epi>
DI void gemm_phase(const Grp& gr, int nshard, const bf16_t* __restrict__ A, const bf16_t* __restrict__ Bt, int N, char* smem, int* ctr, Epi epi) {
  const int tid = opaque_tid(), lane = tid & 63, wave = tid >> 6;
  const int r = lane & 31, h = lane >> 5;
  const int wm = wave >> 1, wn = wave & 1;
  bf16_t* As = (bf16_t*)smem;
  bf16_t* Bs = As + 2 * 128 * GSTR;
  const int tiles_n = N >> 7;
  const int ntiles = 6 * tiles_n;
  bool qfirst = true;
  for (;;) {
    const int tile = next_tile_q(gr, ctr + gr.j * 64, smem, qfirst);
    if (tile >= ntiles) break;
    const int tn = tile % tiles_n, tm = mtile_g(gr.g, gr.j * 6 + tile / tiles_n);
    const int m0 = tm * 128, n0 = tn * 128;
    const bf16_t* Ap = A + (size_t)m0 * DM;
    const bf16_t* Bp = Bt + (size_t)n0 * DM;
    f32x16 acc[2][2];
#pragma unroll
    for (int i = 0; i < 2; ++i)
#pragma unroll
      for (int j = 0; j < 2; ++j)
#pragma unroll
        for (int e = 0; e < 16; ++e) acc[i][j][e] = 0.f;
    u32x4 ra0[4], rb0[4], ra1[4], rb1[4];
    const bf16_t* Ag = Ap + (size_t)(tid >> 3) * DM + (tid & 7) * 8;
    const bf16_t* Bg = Bp + (size_t)(tid >> 3) * DM + (tid & 7) * 8;
    const int lofs = (tid >> 3) * GSTR + (tid & 7) * 8;
#define G_LOAD(RA, RB, KT) { _Pragma("unroll") for (int i = 0; i < 4; ++i) { \
      RA[i] = *(const u32x4*)(Ag + (size_t)i * 32 * DM + (KT) * 64); RB[i] = *(const u32x4*)(Bg + (size_t)i * 32 * DM + (KT) * 64); } }
#define G_STORE(RA, RB, BUF) { _Pragma("unroll") for (int i = 0; i < 4; ++i) { \
      *(u32x4*)(As + (BUF) * 128 * GSTR + lofs + i * 32 * GSTR) = RA[i]; *(u32x4*)(Bs + (BUF) * 128 * GSTR + lofs + i * 32 * GSTR) = RB[i]; } }
#define G_FRAGS(SET, Ac, Bc, KS) { \
        fa0[SET] = *(const bf16x8*)(Ac + (wm * 64 + r) * GSTR + (KS) * 16 + h * 8); \
        fa1[SET] = *(const bf16x8*)(Ac + (wm * 64 + 32 + r) * GSTR + (KS) * 16 + h * 8); \
        fb0[SET] = *(const bf16x8*)(Bc + (wn * 64 + r) * GSTR + (KS) * 16 + h * 8); \
        fb1[SET] = *(const bf16x8*)(Bc + (wn * 64 + 32 + r) * GSTR + (KS) * 16 + h * 8); }
#define G_MFMAS(SET) { __builtin_amdgcn_s_setprio(1); \
        acc[0][0] = MFMA(fa0[SET], fb0[SET], acc[0][0]); acc[0][1] = MFMA(fa0[SET], fb1[SET], acc[0][1]); \
        acc[1][0] = MFMA(fa1[SET], fb0[SET], acc[1][0]); acc[1][1] = MFMA(fa1[SET], fb1[SET], acc[1][1]); __builtin_amdgcn_s_setprio(0); }
#define G_COMPUTE(BUF) { const bf16_t* Ac = As + (BUF) * 128 * GSTR; const bf16_t* Bc = Bs + (BUF) * 128 * GSTR; \
      bf16x8 fa0[2], fa1[2], fb0[2], fb1[2]; \
      G_FRAGS(0, Ac, Bc, 0); \
      __builtin_amdgcn_sched_barrier(0); \
      G_FRAGS(1, Ac, Bc, 1); \
      __builtin_amdgcn_sched_barrier(0); \
      G_MFMAS(0); \
      __builtin_amdgcn_sched_barrier(0); \
      G_FRAGS(0, Ac, Bc, 2); \
      __builtin_amdgcn_sched_barrier(0); \
      G_MFMAS(1); \
      __builtin_amdgcn_sched_barrier(0); \
      G_FRAGS(1, Ac, Bc, 3); \
      __builtin_amdgcn_sched_barrier(0); \
      G_MFMAS(0); \
      __builtin_amdgcn_sched_barrier(0); \
      G_MFMAS(1); \
      __builtin_amdgcn_sched_barrier(0); }
    G_LOAD(ra0, rb0, 0);
    G_LOAD(ra1, rb1, 1);
    G_STORE(ra0, rb0, 0);
    __syncthreads();
#pragma unroll 1
    for (int kt = 0; kt < 16; kt += 2) {
      if (kt + 2 < 16) G_LOAD(ra0, rb0, kt + 2);
      G_COMPUTE(0);
      G_STORE(ra1, rb1, 1);
      __syncthreads();
      if (kt + 3 < 16) G_LOAD(ra1, rb1, kt + 3);
      G_COMPUTE(1);
      if (kt + 2 < 16) G_STORE(ra0, rb0, 0);
      __syncthreads();
    }
#undef G_LOAD
#undef G_STORE
#undef G_COMPUTE
#undef G_FRAGS
#undef G_MFMAS
#pragma unroll
    for (int i = 0; i < 2; ++i)
#pragma unroll
      for (int j = 0; j < 2; ++j) epi(m0 + wm * 64 + i * 32, n0 + wn * 64 + j * 32, acc[i][j], r, h);
  }
}

constexpr int KSTR = 72;
constexpr int VSTR = 136;

struct AttnState { f32x16 o[2]; float m, l; };

DI void stage_k_bf(bf16_t* Ks, const bf16_t* src) {
  int tid = threadIdx.x;
  asm volatile("" : "+v"(tid));
#pragma unroll
  for (int i = 0; i < 4; ++i) {
    int id = tid + 256 * i, row = id >> 3, ch = id & 7;
    *(uint4*)(Ks + row * KSTR + ch * 8) = *(const uint4*)(src + (size_t)row * PC + ch * 8);
  }
}
DI void stage_k_f32(bf16_t* Ks, const float* src, int rstride) {
  int tid = threadIdx.x;
  asm volatile("" : "+v"(tid));
#pragma unroll
  for (int i = 0; i < 4; ++i) {
    int id = tid + 256 * i, row = id >> 3, ch = id & 7;
    const float* s = src + (size_t)row * rstride + ch * 8;
    float4 a = *(const float4*)s, b = *(const float4*)(s + 4);
    uint4 r; r.x = pk2(a.x, a.y); r.y = pk2(a.z, a.w); r.z = pk2(b.x, b.y); r.w = pk2(b.z, b.w);
    *(uint4*)(Ks + row * KSTR + ch * 8) = r;
  }
}
DI void stage_vt_bf(bf16_t* Vt, const bf16_t* src) {
  int tid = threadIdx.x;
  asm volatile("" : "+v"(tid));
#pragma unroll
  for (int i = 0; i < 4; ++i) {
    int id = tid + 256 * i, row = id & 127, ch = id >> 7;
    uint4 v = *(const uint4*)(src + (size_t)row * PC + ch * 8);
    unsigned w[4] = {v.x, v.y, v.z, v.w};
#pragma unroll
    for (int k = 0; k < 4; ++k) {
      Vt[(ch * 8 + 2 * k) * VSTR + row] = (bf16_t)(w[k] & 0xffffu);
      Vt[(ch * 8 + 2 * k + 1) * VSTR + row] = (bf16_t)(w[k] >> 16);
    }
  }
}
DI void stage_vt_f32(bf16_t* Vt, const float* src, int rstride) {
  int tid = threadIdx.x;
  asm volatile("" : "+v"(tid));
#pragma unroll
  for (int i = 0; i < 4; ++i) {
    int id = tid + 256 * i, row = id & 127, ch = id >> 7;
    const float* s = src + (size_t)row * rstride + ch * 8;
    float4 a = *(const float4*)s, b = *(const float4*)(s + 4);
    float f[8] = {a.x, a.y, a.z, a.w, b.x, b.y, b.z, b.w};
#pragma unroll
    for (int k = 0; k < 8; ++k) Vt[(ch * 8 + k) * VSTR + row] = f2bf(f[k]);
  }
}

template <int NKS>
DI void attn_tile(const bf16_t* Ks, int kcol0, const bf16_t* Vt, const bf16x8 (&qf)[NKS], AttnState& st, float cscale,
                  int maskmode, int qpos, int kpos0, int r, int h) {
  f32x16 s[2];
#pragma unroll
  for (int kb = 0; kb < 2; ++kb) {
#pragma unroll
    for (int e = 0; e < 16; ++e) s[kb][e] = 0.f;
#pragma unroll
    for (int ks = 0; ks < NKS; ++ks) {
      bf16x8 a = *(const bf16x8*)(Ks + (kb * 32 + r) * KSTR + kcol0 + ks * 16 + h * 8);
      s[kb] = MFMA(a, qf[ks], s[kb]);
    }
  }
  float tmax = -INFINITY;
#pragma unroll
  for (int kb = 0; kb < 2; ++kb)
#pragma unroll
    for (int e = 0; e < 16; ++e) {
      float v = s[kb][e] * cscale;
      if (maskmode) {
        int kp = kpos0 + kb * 32 + crow(e, h);
        int dd = kp - qpos; dd = dd < 0 ? -dd : dd;
        v = (dd <= 128) ? v : -INFINITY;
      }
      s[kb][e] = v;
      tmax = fmaxf(tmax, v);
    }
  tmax = fmaxf(tmax, __shfl_xor(tmax, 32));
  float mnew = fmaxf(st.m, tmax);
  float alpha = (mnew == -INFINITY) ? 1.f : __builtin_amdgcn_exp2f(st.m - mnew);
  float msub = (mnew == -INFINITY) ? 0.f : mnew;
  float psum = 0.f;
#pragma unroll
  for (int kb = 0; kb < 2; ++kb)
#pragma unroll
    for (int e = 0; e < 16; ++e) {
      float pv = __builtin_amdgcn_exp2f(s[kb][e] - msub);
      s[kb][e] = pv;
      psum += pv;
    }
  st.l = st.l * alpha + psum;
  st.m = mnew;
#pragma unroll
  for (int db = 0; db < 2; ++db)
#pragma unroll
    for (int e = 0; e < 16; ++e) st.o[db][e] *= alpha;
#pragma unroll
  for (int kb = 0; kb < 2; ++kb)
#pragma unroll
    for (int ss = 0; ss < 2; ++ss) {
      uint4 pu;
      pu.x = pk2(s[kb][8 * ss + 0], s[kb][8 * ss + 1]);
      pu.y = pk2(s[kb][8 * ss + 2], s[kb][8 * ss + 3]);
      pu.z = pk2(s[kb][8 * ss + 4], s[kb][8 * ss + 5]);
      pu.w = pk2(s[kb][8 * ss + 6], s[kb][8 * ss + 7]);
      bf16x8 pb = as_bf16x8(pu);
#pragma unroll
      for (int db = 0; db < 2; ++db) {
        const bf16_t* vp = Vt + (db * 32 + r) * VSTR + kb * 32 + 16 * ss + 4 * h;
        s16x4 lo = *(const s16x4*)vp;
        s16x4 hi = *(const s16x4*)(vp + 8);
        bf16x8 va = __builtin_shufflevector(lo, hi, 0, 1, 2, 3, 4, 5, 6, 7);
        st.o[db] = MFMA(va, pb, st.o[db]);
      }
    }
}

DI void store_oT(bf16_t* O, int token, int colbase, const f32x16 (&o)[2], int h) {
#pragma unroll
  for (int db = 0; db < 2; ++db)
#pragma unroll
    for (int g = 0; g < 4; ++g) {
      uint2 u;
      u.x = pk2(o[db][4 * g + 0], o[db][4 * g + 1]);
      u.y = pk2(o[db][4 * g + 2], o[db][4 * g + 3]);
      *(uint2*)(O + (size_t)token * DM + colbase + db * 32 + 8 * g + 4 * h) = u;
    }
}

DI void attn_init(AttnState& st, float m0, float l0) {
#pragma unroll
  for (int db = 0; db < 2; ++db)
#pragma unroll
    for (int e = 0; e < 16; ++e) st.o[db][e] = 0.f;
  st.m = m0;
  st.l = l0;
}

DI void mixer_bc(const Params& p, int l, bool isC, bool lat, int b, int hd, int qb, char* smem) {
  const int tid = opaque_tid(), lane = tid & 63, wave = tid >> 6, r = lane & 31, h = lane >> 5;
  const int qblk = wave >> 1, role = wave & 1;
  bf16_t* Ks = (bf16_t*)smem;
  bf16_t* Vt = Ks + 128 * KSTR;
  float* xch = (float*)smem;
  const bf16_t* P = (const bf16_t*)(p.ws + OFF_P);
  const int kv = hd >> 1;
  const int seq0 = lat ? TCTX + b * 1024 : b * 256;
  const int qpos = qb * 64 + qblk * 32 + r;
  const int qtok = seq0 + qpos;
  const float LOG2E = 1.4426950408889634f;
  bf16x8 qf[4];
  {
    const int qcol = isC ? 1024 + hd * 64 + role * 32 : 512 + hd * 64;
    const bf16_t* qp = P + (size_t)qtok * PC + qcol + h * 8;
    qf[0] = *(const bf16x8*)(qp);
    qf[1] = *(const bf16x8*)(qp + 16);
    qf[2] = qf[0]; qf[3] = qf[1];
    if (!isC) { qf[2] = *(const bf16x8*)(qp + 32); qf[3] = *(const bf16x8*)(qp + 48); }
  }
  const float cscale = isC ? 0.17677669529663687f * LOG2E : 0.125f * LOG2E;
  AttnState st;
  if (isC) attn_init(st, -INFINITY, 0.f);
  else attn_init(st, p.win_sink[l * 4 + hd] * LOG2E, (role == 0 && h == 0) ? 1.f : 0.f);
  const int ntile = isC ? (lat ? 10 : 2) : (lat ? 5 : 2);
  const int band0 = (qb >> 1) - 1;
  u32x4 kreg[4], vreg[4];
  auto tile_exists = [&](int ti) -> bool {
    if (!isC && lat && ti < 3) { int kt = band0 + ti; return kt >= 0 && kt < 8; }
    return true;
  };
  auto tile_load = [&](int ti) {
    const bf16_t *kp, *vp; int stride;
    if (isC) {
      if (lat && ti < 2) {
        const size_t off = ((size_t)(b * DEPTH + l) * 256 + ti * 128) * 256 + hd * 64;
        kp = (const bf16_t*)(p.ws + OFF_CDKB) + off; vp = (const bf16_t*)(p.ws + OFF_CDVB) + off; stride = 256;
      } else {
        const int kt = lat ? ti - 2 : ti;
        const bf16_t* base = P + (size_t)(seq0 + kt * 128) * PC;
        kp = base + 1280 + hd * 64; vp = base + 1536 + hd * 64; stride = PC;
      }
    } else {
      if (lat && ti >= 3) {
        const size_t off = ((size_t)(b * DEPTH + l) * 256 + (ti - 3) * 128) * 128 + kv * 64;
        kp = (const bf16_t*)(p.ws + OFF_CWKB) + off; vp = (const bf16_t*)(p.ws + OFF_CWVB) + off; stride = 128;
      } else {
        const int kt = lat ? band0 + ti : ti;
        const bf16_t* base = P + (size_t)(seq0 + kt * 128) * PC;
        kp = base + 768 + kv * 64; vp = base + 896 + kv * 64; stride = PC;
      }
    }
    int t2 = tid;
    asm volatile("" : "+v"(t2));
#pragma unroll
    for (int i = 0; i < 4; ++i) {
      int id = t2 + 256 * i;
      kreg[i] = *(const u32x4*)(kp + (size_t)(id >> 3) * stride + (id & 7) * 8);
      vreg[i] = *(const u32x4*)(vp + (size_t)(id & 127) * stride + (id >> 7) * 8);
    }
  };
  auto tile_store = [&]() {
    int t2 = tid;
    asm volatile("" : "+v"(t2));
#pragma unroll
    for (int i = 0; i < 4; ++i) {
      int id = t2 + 256 * i;
      *(u32x4*)(Ks + (id >> 3) * KSTR + (id & 7) * 8) = kreg[i];
      const int row = id & 127, ch = id >> 7;
#pragma unroll
      for (int k = 0; k < 4; ++k) {
        Vt[(ch * 8 + 2 * k) * VSTR + row] = (bf16_t)(vreg[i][k] & 0xffffu);
        Vt[(ch * 8 + 2 * k + 1) * VSTR + row] = (bf16_t)(vreg[i][k] >> 16);
      }
    }
  };
  if (tile_exists(0)) tile_load(0);
#pragma unroll 1
  for (int ti = 0; ti < ntile; ++ti) {
    const bool ex = tile_exists(ti);
    __syncthreads();
    if (ex) tile_store();
    __syncthreads();
    if (ti + 1 < ntile && tile_exists(ti + 1)) tile_load(ti + 1);
    if (ex) {
      if (isC) {
        const bf16x8 q2[2] = {qf[0], qf[1]};
#pragma unroll 1
        for (int hf = 0; hf < 2; ++hf)
          attn_tile<2>(Ks + hf * 64 * KSTR, role * 32, Vt + hf * 64, q2, st, cscale, 0, 0, 0, r, h);
      } else {
        const bool band = lat && ti < 3;
        const int kpos0 = (band0 + ti) * 128 + role * 64;
        attn_tile<4>(Ks + role * 64 * KSTR, 0, Vt + role * 64, qf, st, cscale, band ? 1 : 0, qpos, kpos0, r, h);
      }
    }
  }
  __syncthreads();
  float* xp = xch + (size_t)(qblk * 64 + lane) * 36;
  if (role == 1) {
#pragma unroll
    for (int db = 0; db < 2; ++db)
#pragma unroll
      for (int g = 0; g < 4; ++g)
        *(float4*)(xp + db * 16 + g * 4) = make_float4(st.o[db][4 * g], st.o[db][4 * g + 1], st.o[db][4 * g + 2], st.o[db][4 * g + 3]);
    xp[32] = st.m; xp[33] = st.l;
  }
  __syncthreads();
  if (role == 0) {
    f32x16 o1[2];
#pragma unroll
    for (int db = 0; db < 2; ++db)
#pragma unroll
      for (int g = 0; g < 4; ++g) {
        float4 v = *(const float4*)(xp + db * 16 + g * 4);
        o1[db][4 * g] = v.x; o1[db][4 * g + 1] = v.y; o1[db][4 * g + 2] = v.z; o1[db][4 * g + 3] = v.w;
      }
    const float m1 = xp[32], l1 = xp[33];
    if (isC) {
      const float lam = ((const float*)(p.ws + OFF_LAM))[l];
      const float lam_init = ((const float*)(p.ws + OFF_LAM))[4 + l];
      float i0 = 1.f / (st.l + __shfl_xor(st.l, 32));
      float i1 = lam / (l1 + __shfl_xor(l1, 32));
      float ss = 0.f;
#pragma unroll
      for (int db = 0; db < 2; ++db)
#pragma unroll
        for (int e = 0; e < 16; ++e) {
          float w = st.o[db][e] * i0 - o1[db][e] * i1;
          st.o[db][e] = w;
          ss += w * w;
        }
      ss += __shfl_xor(ss, 32);
      float rs = rsqrtf(ss * (1.f / 64.f) + LN_EPS) * (1.f - lam_init);
#pragma unroll
      for (int db = 0; db < 2; ++db)
#pragma unroll
        for (int e = 0; e < 16; ++e) st.o[db][e] *= rs * p.subln_g[l * 64 + db * 32 + crow(e, h)];
      store_oT((bf16_t*)(p.ws + OFF_O), qtok, 512 + hd * 64, st.o, h);
    } else {
      const float m = fmaxf(st.m, m1);
      const float a0 = __builtin_amdgcn_exp2f(st.m - m), a1 = __builtin_amdgcn_exp2f(m1 - m);
      float lt = st.l * a0 + l1 * a1;
      lt += __shfl_xor(lt, 32);
      const float inv = 1.f / lt;
      const float c0 = a0 * inv, c1 = a1 * inv;
#pragma unroll
      for (int db = 0; db < 2; ++db)
#pragma unroll
        for (int e = 0; e < 16; ++e) st.o[db][e] = st.o[db][e] * c0 + o1[db][e] * c1;
      store_oT((bf16_t*)(p.ws + OFF_O), qtok, 256 + hd * 64, st.o, h);
    }
  }
}

DI void mixer_a(const Params& p, int l, int ch, int hd, char* smem) {
  const int tid = opaque_tid(), lane = tid & 63, wave = tid >> 6, r = lane & 31, h = lane >> 5;
  bf16_t* Vt = (bf16_t*)smem;
  const bf16_t* P = (const bf16_t*)(p.ws + OFF_P);
  const int tok0 = ch * 128;
  __syncthreads();
  stage_vt_bf(Vt, P + (size_t)tok0 * PC + 256 + hd * 64);
  __syncthreads();
  const int pp = wave * 32 + r;
  const float* wrow = p.chunk_w + ((size_t)(l * 4 + hd) * 128 + pp) * 128;
  f32x16 acc[2];
#pragma unroll
  for (int db = 0; db < 2; ++db)
#pragma unroll
    for (int e = 0; e < 16; ++e) acc[db][e] = 0.f;
#pragma unroll
  for (int ks = 0; ks < 8; ++ks) {
    float4 a = *(const float4*)(wrow + ks * 16 + 8 * h), b = *(const float4*)(wrow + ks * 16 + 8 * h + 4);
    uint4 wu; wu.x = pk2(a.x, a.y); wu.y = pk2(a.z, a.w); wu.z = pk2(b.x, b.y); wu.w = pk2(b.z, b.w);
    bf16x8 wb = as_bf16x8(wu);
#pragma unroll
    for (int db = 0; db < 2; ++db) {
      bf16x8 va = *(const bf16x8*)(Vt + (db * 32 + r) * VSTR + ks * 16 + 8 * h);
      acc[db] = MFMA(va, wb, acc[db]);
    }
  }
  const float bias = p.chunk_b[(l * 4 + hd) * 128 + pp];
  const int token = tok0 + pp;
#pragma unroll
  for (int db = 0; db < 2; ++db)
#pragma unroll
    for (int g = 0; g < 4; ++g) {
      uint2 uu = *(const uint2*)(P + (size_t)token * PC + hd * 64 + db * 32 + 8 * g + 4 * h);
      acc[db][4 * g + 0] = bflo(uu.x) * (acc[db][4 * g + 0] + bias);
      acc[db][4 * g + 1] = bfhi(uu.x) * (acc[db][4 * g + 1] + bias);
      acc[db][4 * g + 2] = bflo(uu.y) * (acc[db][4 * g + 2] + bias);
      acc[db][4 * g + 3] = bfhi(uu.y) * (acc[db][4 * g + 3] + bias);
    }
  store_oT((bf16_t*)(p.ws + OFF_O), token, hd * 64, acc, h);
}

DI void mixer_d(const Params& p, int l, int ch, int g) {
  const int tid = opaque_tid(), lane = tid & 63, wave = tid >> 6, r = lane & 31, h = lane >> 5;
  const bf16_t* P = (const bf16_t*)(p.ws + OFF_P);
  const int token = ch * 128 + wave * 32 + r;
  int s0, slen;
  if (token < TCTX) { s0 = token & ~255; slen = 256; } else { s0 = TCTX + ((token - TCTX) & ~1023); slen = 1024; }
  const int pos = token - s0;
  const int w = 2 << g, hw = w >> 1;
  int lo = pos - hw; if (lo < 0) lo = 0;
  int hi = pos + hw; if (hi > slen) hi = slen;
  const float icnt = 1.f / (float)(hi - lo);
  const float* wp = p.pool_w + (size_t)(l * 4 + g) * 64 * 64;
  f32x16 acc[2];
#pragma unroll
  for (int db = 0; db < 2; ++db)
#pragma unroll
    for (int e = 0; e < 16; ++e) acc[db][e] = 0.f;
#pragma unroll
  for (int ks = 0; ks < 4; ++ks) {
    const int cbase = 1792 + g * 64 + ks * 16 + 8 * h;
    float sum[8];
#pragma unroll
    for (int k = 0; k < 8; ++k) sum[k] = 0.f;
    for (int i = 0; i < w; ++i) {
      int tt = pos - hw + i;
      if (tt >= 0 && tt < slen) {
        uint4 v = *(const uint4*)(P + (size_t)(s0 + tt) * PC + cbase);
        sum[0] += bflo(v.x); sum[1] += bfhi(v.x); sum[2] += bflo(v.y); sum[3] += bfhi(v.y);
        sum[4] += bflo(v.z); sum[5] += bfhi(v.z); sum[6] += bflo(v.w); sum[7] += bfhi(v.w);
      }
    }
    uint4 zv = *(const uint4*)(P + (size_t)token * PC + cbase);
    float z[8] = {bflo(zv.x), bfhi(zv.x), bflo(zv.y), bfhi(zv.y), bflo(zv.z), bfhi(zv.z), bflo(zv.w), bfhi(zv.w)};
    float pl[8];
#pragma unroll
    for (int k = 0; k < 8; ++k) pl[k] = sum[k] * icnt - z[k];
    bf16x8 pb = as_bf16x8(pack8(pl));
#pragma unroll
    for (int db = 0; db < 2; ++db) {
      float wv[8];
#pragma unroll
      for (int k = 0; k < 8; ++k) wv[k] = wp[(ks * 16 + 8 * h + k) * 64 + db * 32 + r];
      bf16x8 wa = as_bf16x8(pack8(wv));
      acc[db] = MFMA(wa, pb, acc[db]);
    }
  }
#pragma unroll
  for (int db = 0; db < 2; ++db)
#pragma unroll
    for (int e = 0; e < 16; ++e) acc[db][e] *= p.pool_scale[l * 256 + g * 64 + db * 32 + crow(e, h)];
  store_oT((bf16_t*)(p.ws + OFF_O), token, 768 + g * 64, acc, h);
}

DI void phase_mixers(const Grp& gr, int nshard, const Params& p, int l, char* smem, int* ctr) {
  bool qfirst = true;
  for (;;) {
    const int it = next_item(gr, ctr, smem, qfirst, nshard);
    if (it >= 576) break;
    if (it < 384) {
      bool lat, cmix; int b, hd, qb;
      if (it < 128) { int q = it & 63; lat = true; cmix = it < 64; b = gr.g; hd = (q >> 4) & 3; qb = q & 15; }
      else { int q = (it - 128) & 127; lat = false; cmix = it < 256; b = gr.g * 8 + (q >> 4); hd = (q >> 2) & 3; qb = q & 3; }
      mixer_bc(p, l, cmix, lat, b, hd, qb, smem);
    } else if (it < 480) { int q = it - 384; mixer_a(p, l, mtile_g(gr.g, q >> 2), q & 3, smem); }
    else { int q = it - 480; mixer_d(p, l, mtile_g(gr.g, q >> 2), q & 3); }
  }
}

constexpr int PKSTR = 68;
constexpr int PKJ = 128 * PKSTR + 16;

typedef float f32x4 __attribute__((ext_vector_type(4)));
DI void phase_peer(const Grp& gr, const Params& p, int l, char* smem, bool dry) {
  const int tid = opaque_tid(), lane = tid & 63, wave = tid >> 6;
  unsigned* scr3 = (unsigned*)smem + wave * 1024;
  unsigned* eidx = scr3 + 768;
  float* egate = (float*)(scr3 + 896);
  __syncthreads();
  int ci = 0, cj = 0;
  {
    int L = lane, i = 0;
    while (i < 16 && L >= 16 / (i + 1)) { L -= 16 / (i + 1); ++i; }
    ci = i; cj = L;
  }
  const bool cvalid = lane < 50;
  if (!cvalid) { ci = 0; cj = 0; }
  const float* X = (const float*)(p.ws + OFF_X);
  float* Xw = (float*)(p.ws + (dry ? OFF_X2 : OFF_X));
  const bf16_t* Qb = (const bf16_t*)(p.ws + OFF_Q);
  const bf16_t* KB = (const bf16_t*)(p.ws + OFF_KEYB) + (size_t)l * 2 * 128 * 64;
  const bf16_t* H = (const bf16_t*)(p.ws + OFF_H);
  bf16_t* Hw = (bf16_t*)(p.ws + (dry ? OFF_H2 : OFF_H));
  float* Yw = dry ? (float*)(p.ws + OFF_X2) : p.out + OUT_Y;
  const float* mod = (const float*)(p.ws + OFF_MOD);
  const unsigned char* U8 = (const unsigned char*)(p.ws + OFF_UB) + (size_t)l * NEXP * 2048;
  const unsigned char* V8 = U8 + 1024;
  const float* USC = (const float*)(p.ws + OFF_USC) + (size_t)l * NEXP;
  const float* VSC = (const float*)(p.ws + OFF_VSC) + (size_t)l * NEXP;
  const int gw = gr.lq * 4 + wave, nw = gr.QB * 4;
  const int q0 = gr.j * QTOK;
#pragma unroll 1
  for (int tb = gw; tb < QTOK; tb += 3 * nw) {
    {
      const int c16 = lane & 15, quad = lane >> 4;
#pragma unroll 1
      for (int jc = 0; jc < 4; ++jc) {
        const int j = jc >> 1, c = (jc & 1) * 16 + c16;
        int ti = c >> 3; if (ti > 2) ti = 2;
        const int hh = c & 7;
        int tok = tb + ti * nw; if (tok >= QTOK) tok = tb;
        tok = tok_g(gr.g, q0 + tok);
        const bf16_t* qp = Qb + (size_t)tok * DM + hh * 128 + j * 64 + quad * 8;
        const bf16x8 b0 = *(const bf16x8*)qp, b1 = *(const bf16x8*)(qp + 32);
        const bf16_t* kp = KB + (size_t)(j * 128 + c16) * 64 + quad * 8;
        float top[16];
#pragma unroll
        for (int s = 0; s < 16; ++s) top[s] = -3.0e38f;
#pragma unroll
        for (int nb = 0; nb < 8; ++nb) {
          const bf16x8 a0 = *(const bf16x8*)(kp + nb * 16 * 64), a1 = *(const bf16x8*)(kp + nb * 16 * 64 + 32);
          f32x4 acc = {0.f, 0.f, 0.f, 0.f};
          acc = __builtin_amdgcn_mfma_f32_16x16x32_bf16(a0, b0, acc, 0, 0, 0);
          acc = __builtin_amdgcn_mfma_f32_16x16x32_bf16(a1, b1, acc, 0, 0, 0);
#pragma unroll
          for (int e = 0; e < 4; ++e) {
            float v = __uint_as_float((__float_as_uint(acc[e]) & ~0x7Fu) | (unsigned)(nb * 16 + quad * 4 + e));
#pragma unroll
            for (int s = 0; s < 16; ++s) {
              float hi_ = fmaxf(top[s], v);
              v = fminf(top[s], v);
              top[s] = hi_;
            }
          }
        }
#pragma unroll
        for (int step = 16; step <= 32; step <<= 1) {
          float oth[16];
#pragma unroll
          for (int s = 0; s < 16; ++s) oth[s] = __shfl_xor(top[s], step);
#pragma unroll
          for (int s = 0; s < 16; ++s) top[s] = fmaxf(top[s], oth[15 - s]);
#pragma unroll
          for (int dist = 8; dist >= 1; dist >>= 1) {
#pragma unroll
            for (int s = 0; s < 16; ++s) {
              if ((s & dist) == 0) {
                float a = top[s], b = top[s + dist];
                top[s] = fmaxf(a, b);
                top[s + dist] = fminf(a, b);
              }
            }
          }
        }
        if (quad == 0 && c < 24) {
          unsigned* dstp = scr3 + ((c >> 3) * 16 + 2 * hh + j) * 16;
#pragma unroll
          for (int s4 = 0; s4 < 4; ++s4)
            *(uint4*)(dstp + s4 * 4) = make_uint4(__float_as_uint(top[s4 * 4 + 0]), __float_as_uint(top[s4 * 4 + 1]),
                                                  __float_as_uint(top[s4 * 4 + 2]), __float_as_uint(top[s4 * 4 + 3]));
        }
      }
    }
    __builtin_amdgcn_fence(__ATOMIC_RELEASE, "wavefront");
    __builtin_amdgcn_wave_barrier();
    __builtin_amdgcn_fence(__ATOMIC_ACQUIRE, "wavefront");
#pragma unroll 1
    for (int ti3 = 0; ti3 < 3; ++ti3) {
    if (tb + ti3 * nw >= QTOK) break;
    const int t = tok_g(gr.g, q0 + tb + ti3 * nw);
    unsigned* scr = scr3 + ti3 * 256;
    for (int hd = 0; hd < 8; ++hd) {
      unsigned ka = scr[(2 * hd) * 16 + ci], kb = scr[(2 * hd + 1) * 16 + cj];
      float cand = cvalid ? (__uint_as_float(ka & ~0x7Fu) + __uint_as_float(kb & ~0x7Fu)) : -3.0e38f;
      int rank = 0;
#pragma unroll
      for (int m = 0; m < 50; ++m) {
        float sv = __uint_as_float(__builtin_amdgcn_readlane(__float_as_uint(cand), m));
        rank += (sv > cand) ? 1 : 0;
      }
      bool sel = cvalid && rank < 16;
      unsigned long long bm = __ballot(sel);
      int slot = __builtin_amdgcn_mbcnt_hi((unsigned)(bm >> 32), __builtin_amdgcn_mbcnt_lo((unsigned)bm, 0));
      unsigned long long b0 = __ballot(cvalid && rank == 0);
      int l0 = __ffsll((long long)b0) - 1;
      float mx = __uint_as_float(__builtin_amdgcn_readlane(__float_as_uint(cand), l0));
      float e = sel ? __expf(cand - mx) : 0.f;
      float sum = wave_sum(e);
      if (sel && slot < 16) {
        eidx[hd * 16 + slot] = (ka & 0x7Fu) * 128u + (kb & 0x7Fu);
        egate[hd * 16 + slot] = e / sum;
      }
    }
    __builtin_amdgcn_fence(__ATOMIC_RELEASE, "wavefront");
    __builtin_amdgcn_wave_barrier();
    __builtin_amdgcn_fence(__ATOMIC_ACQUIRE, "wavefront");
    const float* modv = mod + (size_t)(l * 3 + tok_grp(t)) * 6144;
    f2v_t h2[8], outp[8];
    {
#pragma unroll
      for (int j = 0; j < 4; ++j) {
        const uint2 hu = *(const uint2*)(H + (size_t)t * DM + j * 256 + lane * 4);
        h2[2 * j] = f2v_t{bflo(hu.x), bfhi(hu.x)};
        h2[2 * j + 1] = f2v_t{bflo(hu.y), bfhi(hu.y)};
      }
#pragma unroll
      for (int w = 0; w < 8; ++w) outp[w] = f2v_t{0.f, 0.f};
    }
    {
      float* eus = (float*)scr;
#pragma unroll
      for (int j = 0; j < 2; ++j) {
        const int i = lane + 64 * j;
        const unsigned id = eidx[i];
        eus[i] = USC[id];
        eus[128 + i] = egate[i] * VSC[id];
      }
    }
    __builtin_amdgcn_fence(__ATOMIC_RELEASE, "wavefront");
    __builtin_amdgcn_wave_barrier();
    __builtin_amdgcn_fence(__ATOMIC_ACQUIRE, "wavefront");
    const float* eus = (const float*)scr;
    u32x4 ub[16], vb[16];
#pragma unroll 1
    for (int hd = 0; hd < 8; ++hd) {
#pragma unroll
      for (int k = 0; k < 16; ++k) {
        unsigned id = __builtin_amdgcn_readfirstlane(eidx[hd * 16 + k]);
        ub[k] = *(const u32x4*)(U8 + ((size_t)id << 11) + lane * 16);
      }
#pragma unroll
      for (int k = 0; k < 16; ++k) {
        unsigned id = __builtin_amdgcn_readfirstlane(eidx[hd * 16 + k]);
        vb[k] = *(const u32x4*)(V8 + ((size_t)id << 11) + lane * 16);
      }
      float pd[16];
#pragma unroll
      for (int k = 0; k < 16; ++k) {
        f2v_t acc = {0.f, 0.f};
#pragma unroll
        for (int w = 0; w < 4; ++w) {
          acc = __builtin_elementwise_fma(__builtin_amdgcn_cvt_pk_f32_fp8((int)ub[k][w], false), h2[2 * w], acc);
          acc = __builtin_elementwise_fma(__builtin_amdgcn_cvt_pk_f32_fp8((int)ub[k][w], true), h2[2 * w + 1], acc);
        }
        pd[k] = acc.x + acc.y;
      }
      const bool b0 = lane & 1, b1 = lane & 2, b2 = lane & 4, b3 = lane & 8;
      float w8[8], w4[4], w2[2], z;
#pragma unroll
      for (int i = 0; i < 8; ++i) { float snd = b0 ? pd[i] : pd[8 + i], kp = b0 ? pd[8 + i] : pd[i]; w8[i] = kp + __shfl_xor(snd, 1); }
#pragma unroll
      for (int i = 0; i < 4; ++i) { float snd = b1 ? w8[i] : w8[4 + i], kp = b1 ? w8[4 + i] : w8[i]; w4[i] = kp + __shfl_xor(snd, 2); }
#pragma unroll
      for (int i = 0; i < 2; ++i) { float snd = b2 ? w4[i] : w4[2 + i], kp = b2 ? w4[2 + i] : w4[i]; w2[i] = kp + __shfl_xor(snd, 4); }
      { float snd = b3 ? w2[0] : w2[1], kp = b3 ? w2[1] : w2[0]; z = kp + __shfl_xor(snd, 8); }
      z += __shfl_xor(z, 16); z += __shfl_xor(z, 32);
      const int kmine = ((lane & 1) << 3) | ((lane & 2) << 1) | ((lane & 4) >> 1) | ((lane & 8) >> 3);
      const float cfl = eus[128 + hd * 16 + kmine] * gelu_t(z * eus[hd * 16 + kmine]);
#pragma unroll
      for (int k = 0; k < 16; ++k) {
        const int src = ((k >> 3) & 1) | (((k >> 2) & 1) << 1) | (((k >> 1) & 1) << 2) | ((k & 1) << 3);
        const float cf = __uint_as_float(__builtin_amdgcn_readlane(__float_as_uint(cfl), src));
        const f2v_t c2 = {cf, cf};
#pragma unroll
        for (int w = 0; w < 4; ++w) {
          outp[2 * w] = __builtin_elementwise_fma(__builtin_amdgcn_cvt_pk_f32_fp8((int)vb[k][w], false), c2, outp[2 * w]);
          outp[2 * w + 1] = __builtin_elementwise_fma(__builtin_amdgcn_cvt_pk_f32_fp8((int)vb[k][w], true), c2, outp[2 * w + 1]);
        }
      }
    }
    float x1[16], outv[16];
#pragma unroll
    for (int w = 0; w < 8; ++w) { outv[2 * w] = outp[w].x; outv[2 * w + 1] = outp[w].y; }
    load_row16(X + (size_t)t * DM, lane, x1);
    {
      float g2[16], g[16], bb[16];
      load_row16(modv + 5120, lane, g2);
      load_row16(p.ln_g + (size_t)(l * 2 + 1) * DM, lane, g);
      load_row16(p.ln_b + (size_t)(l * 2 + 1) * DM, lane, bb);
#pragma unroll
      for (int i = 0; i < 16; ++i) x1[i] = ALPHA * x1[i] + g2[i] * outv[i];
      float mu, rstd;
      ln_stats(x1, mu, rstd);
#pragma unroll
      for (int i = 0; i < 16; ++i) x1[i] = (x1[i] - mu) * rstd * g[i] + bb[i];
      if (l == DEPTH - 1) {
        store_row16(Yw + (size_t)t * DM, lane, x1);
      } else {
        store_row16(Xw + (size_t)t * DM, lane, x1);
        const float* modn = mod + (size_t)((l + 1) * 3 + tok_grp(t)) * 6144;
        ln_stats(x1, mu, rstd);
        float sh[16], scv[16];
        load_row16(modn, lane, sh);
        load_row16(modn + 1024, lane, scv);
#pragma unroll
        for (int i = 0; i < 16; ++i) x1[i] = (x1[i] - mu) * rstd * (1.f + scv[i]) + sh[i];
#pragma unroll
        for (int j = 0; j < 4; ++j) {
          uint2 hu; hu.x = pk2(x1[4 * j], x1[4 * j + 1]); hu.y = pk2(x1[4 * j + 2], x1[4 * j + 3]);
          *(uint2*)(Hw + (size_t)t * DM + j * 256 + lane * 4) = hu;
        }
      }
    }
    }
  }
}

struct EpiG1 {
  const Params* p; int l;
  DI void operator()(int rb, int cb, const f32x16& acc, int r, int h) const {
    bf16_t* P = (bf16_t*)(p->ws + OFF_P);
    const int col = cb + r;
    const bool lat = rb >= TCTX;
    float v[16];
#pragma unroll
    for (int e = 0; e < 16; ++e) v[e] = acc[e];
    if (cb < 512) {
#pragma unroll
      for (int e = 0; e < 16; ++e) v[e] = gelu_t(v[e]);
    } else if (lat) {
      const bool ropeB = (cb < 896);
      const bool ropeC = (cb >= 1024 && cb < 1536);
      if (ropeB || ropeC) {
        const int dim = ropeB ? 64 : 32, q = ropeB ? 16 : 8;
        const float* tab = (const float*)(p->ws + (ropeB ? OFF_ROPEB : OFF_ROPEC));
        const int di = col & (dim - 1);
        const bool up = (di & q) != 0;
#pragma unroll
        for (int e = 0; e < 16; ++e) {
          int pos = (rb + crow(e, h) - TCTX) & 1023;
          float partner = __shfl_xor(v[e], q);
          float cs = tab[pos * dim + di], sn = tab[1024 * dim + pos * dim + di];
          v[e] = v[e] * cs + (up ? partner : -partner) * sn;
        }
      }
    }
#pragma unroll
    for (int e = 0; e < 16; ++e) P[(size_t)(rb + crow(e, h)) * PC + col] = f2bf(v[e]);
    if (!lat) {
      float* dst = nullptr; int width = 0, c0 = 0;
      if (cb >= 768 && cb < 896) { dst = p->out + OUT_WK; width = 128; c0 = 768; }
      else if (cb >= 896 && cb < 1024) { dst = p->out + OUT_WV; width = 128; c0 = 896; }
      else if (cb >= 1280 && cb < 1536) { dst = p->out + OUT_DK; width = 256; c0 = 1280; }
      else if (cb >= 1536 && cb < 1792) { dst = p->out + OUT_DV; width = 256; c0 = 1536; }
      if (dst) {
#pragma unroll
        for (int e = 0; e < 16; ++e) {
          int t = rb + crow(e, h), b = t >> 8, s = t & 255;
          __builtin_nontemporal_store(v[e], &dst[((size_t)(b * DEPTH + l) * 256 + s) * width + (col - c0)]);
        }
      }
    }
  }
};
struct EpiG2 {
  const Params* p; int l; bool dry;
  DI void operator()(int rb, int cb, const f32x16& acc, int r, int h) const {
    const float* X = (const float*)(p->ws + OFF_X);
    float* Xo = (float*)(p->ws + (dry ? OFF_X2 : OFF_X));
    const int col = cb + r;
    const float g1 = ((const float*)(p->ws + OFF_MOD))[(size_t)(l * 3 + tok_grp(rb)) * 6144 + 2048 + col];
#pragma unroll
    for (int e = 0; e < 16; ++e) {
      size_t idx = (size_t)(rb + crow(e, h)) * DM + col;
      Xo[idx] = ALPHA * X[idx] + g1 * acc[e];
    }
  }
};
struct EpiG3 {
  const Params* p;
  DI void operator()(int rb, int cb, const f32x16& acc, int r, int h) const {
    bf16_t* Q = (bf16_t*)(p->ws + OFF_Q);
    const int col = cb + r;
#pragma unroll
    for (int e = 0; e < 16; ++e) Q[(size_t)(rb + crow(e, h)) * DM + col] = f2bf(acc[e]);
  }
};

#define XB_TMO      128
#define XB_XCNT(j)  (256  + 64 * (j))
#define XB_XSUB(j)  (1280 + 64 * (j))
#define XB_XGEN(j)  (2304 + 64 * (j))
#define XB_TOP      3328
#define XB_TOPGEN   3392
#define XCD_BAR_WORDS 3456
#define XB_SPIN_CAP (1u << 18)
#define LAS __attribute__((address_space(3)))
DI unsigned xb_ld(unsigned* p) { return __hip_atomic_load(p, __ATOMIC_RELAXED, __HIP_MEMORY_SCOPE_AGENT); }
DI unsigned xb_add(unsigned* p, unsigned v) { return __hip_atomic_fetch_add(p, v, __ATOMIC_RELAXED, __HIP_MEMORY_SCOPE_AGENT); }
DI unsigned xb_xcc_id() { return (unsigned)__builtin_amdgcn_s_getreg((3 << 11) | 20) & 0xFu; }
#define XB_SPIN(cond, bar) do { unsigned _sp = 0; while (cond) { __builtin_amdgcn_s_sleep(1); \
    if ((++_sp & 255u) == 0u) { if (xb_ld(&(bar)[XB_TMO])) break; if (_sp > XB_SPIN_CAP) { atomicAdd(&(bar)[XB_TMO], 1u); break; } } } } while (0)
struct XcdBarrier { unsigned* bar; unsigned x; volatile LAS unsigned* st; };
DI XcdBarrier xcd_barrier_post(unsigned* bar, volatile LAS unsigned* st) {
  XcdBarrier b; b.bar = bar; b.x = xb_xcc_id(); b.st = st;
  if (threadIdx.x == 0) (void)xb_add(&bar[XB_XCNT(b.x)], 1u);
  return b;
}
DI void xcd_barrier_complete(unsigned* bar, unsigned x, unsigned& nloc, unsigned& nx, unsigned G) {
  unsigned sum, cnt, mine, sp = 0u;
  for (;;) {
    sum = 0u; cnt = 0u; mine = 0u;
#pragma unroll
    for (unsigned j = 0; j < 16; ++j) { const unsigned c = xb_ld(&bar[XB_XCNT(j)]); sum += c; cnt += (c > 0u) ? 1u : 0u; mine = (j == x) ? c : mine; }
    if (sum == G) break;
    __builtin_amdgcn_s_sleep(1);
    if ((++sp & 255u) == 0u) { if (xb_ld(&bar[XB_TMO])) break; if (sp > XB_SPIN_CAP) { atomicAdd(&bar[XB_TMO], 1u); break; } }
  }
  nloc = mine > 0u ? mine : 1u; nx = cnt > 0u ? cnt : 1u;
}
DI void xcd_barrier(unsigned* bar_, volatile LAS unsigned* st_, unsigned G) {
  XcdBarrier b; b.bar = bar_; b.x = xb_xcc_id(); b.st = st_;
  asm volatile("s_waitcnt vmcnt(0)" ::: "memory");
  __syncthreads();
  if (threadIdx.x == 0) {
    unsigned* bar = b.bar;
    __builtin_amdgcn_s_waitcnt(0);
    unsigned nloc = b.st[0], nx = b.st[1];
    if (nloc == 0u) { xcd_barrier_complete(bar, b.x, nloc, nx, G); b.st[0] = nloc; b.st[1] = nx; }
    const unsigned old = xb_add(&bar[XB_XSUB(b.x)], 1u);
    const unsigned gen = old / nloc;
    if (old + 1u == (gen + 1u) * nloc) {
      __builtin_amdgcn_fence(__ATOMIC_RELEASE, "agent");
      asm volatile("s_waitcnt vmcnt(0)" ::: "memory");
      const unsigned og = xb_add(&bar[XB_TOP], 1u);
      const unsigned tg = og / nx;
      if (og + 1u == (tg + 1u) * nx) xb_add(&bar[XB_TOPGEN], 1u);
      else XB_SPIN(xb_ld(&bar[XB_TOPGEN]) == tg, bar);
      __builtin_amdgcn_fence(__ATOMIC_ACQUIRE, "agent");
      xb_add(&bar[XB_XGEN(b.x)], 1u);
      asm volatile("s_waitcnt vmcnt(0)" ::: "memory");
    } else {
      XB_SPIN(xb_ld(&bar[XB_XGEN(b.x)]) == gen, bar);
      __builtin_amdgcn_fence(__ATOMIC_ACQUIRE, "agent");
      asm volatile("s_waitcnt vmcnt(0)" ::: "memory");
    }
  }
  __syncthreads();
}

constexpr int SMEM_BYTES = 78848;
static_assert(SMEM_BYTES >= 4 * 1024 * 4, "peer smem");
static_assert(SMEM_BYTES >= 2 * 2 * 128 * GSTR * 2, "gemm smem");
static_assert(SMEM_BYTES >= (128 * KSTR + 64 * VSTR) * 2, "attn smem");

__global__ void __launch_bounds__(NTHR, 2) fwd_megakernel(Params p) {
  __shared__ __attribute__((aligned(16))) char smem[SMEM_BYTES];
  __shared__ uint4 xb_words, xg_words;
  cg::grid_group grid = cg::this_grid();
  if (threadIdx.x == 0) { xb_words = make_uint4(0u, 0u, 0u, 0u); xg_words = make_uint4(0u, 0u, 0u, 0u); }
  __syncthreads();
  const Grp gr = my_grp();
  unsigned* gbar = (unsigned*)(p.ws + OFF_BAR);
  unsigned* mbar = (unsigned*)(p.ws + OFF_BAR + (size_t)(1 + gr.g) * 16384);
  unsigned* flag = (unsigned*)(p.ws + OFF_BAR + 3 * 16384);
  (void)xcd_barrier_post(gbar, (volatile LAS unsigned*)&xb_words);
  (void)xcd_barrier_post(mbar, (volatile LAS unsigned*)&xg_words);
  if (p.ws == nullptr) grid.sync();
#define GBARRIER() xcd_barrier(gbar, (volatile LAS unsigned*)&xb_words, gridDim.x)
#define MBARRIER() xcd_barrier(mbar, (volatile LAS unsigned*)&xg_words, (unsigned)gr.GB)
  phase0(p, smem);
  GBARRIER();
  const int nshard = 8;
  phase_modreduce(p);
  GBARRIER();
  phase_ln0(p);
  GBARRIER();
  if (SPLIT_OFFSET && gr.g == 1) {
    convert_tables(p, 2 * NEXP, 4 * NEXP, gr.lb * 4 + (int)(threadIdx.x >> 6), gr.GB * 4);
    __threadfence();
    __syncthreads();
    if (threadIdx.x == 0) atomicAdd(flag, 1u);
  }
  int* ctr = (int*)(p.ws + OFF_QCTR) + gr.g * (32 * 512);
  for (int l = 0; l < DEPTH; ++l) {
    gemm_phase(gr, nshard, (const bf16_t*)(p.ws + OFF_H), (const bf16_t*)(p.ws + OFF_WINT) + (size_t)l * PC * DM, PC, smem, ctr + ((l * 4 + 0) * 2) * 512, EpiG1{&p, l});
    MBARRIER();
    phase_mixers(gr, nshard, p, l, smem, ctr + ((l * 4 + 1) * 2) * 512);
    MBARRIER();
    gemm_phase(gr, nshard, (const bf16_t*)(p.ws + OFF_O), (const bf16_t*)(p.ws + OFF_WOUTT) + (size_t)l * DM * DM, DM, smem, ctr + ((l * 4 + 2) * 2) * 512, EpiG2{&p, l, false});
    MBARRIER();
    phase_ln1(gr, p, l, false);
    MBARRIER();
    gemm_phase(gr, nshard, (const bf16_t*)(p.ws + OFF_H), (const bf16_t*)(p.ws + OFF_WQT) + (size_t)l * DM * DM, DM, smem, ctr + ((l * 4 + 3) * 2) * 512, EpiG3{&p});
    if (SPLIT_OFFSET && l == 2 && gr.g == 0) {
      if (threadIdx.x == 0) { XB_SPIN(xb_ld(flag) < (unsigned)gr.GB, gbar); }
      __syncthreads();
    }
    MBARRIER();
    phase_peer(gr, p, l, smem, false);
    if (l + 1 < DEPTH) MBARRIER();
  }
}

extern "C" void kernel_launch(void* const* d_in, const int* in_sizes, int n_in, void* d_out, int out_size, void* d_ws,
                              size_t ws_size, hipStream_t stream) {
  static int grid_blocks = 0;
  if (!grid_blocks) {
    int dev = 0, cus = 0, per_cu = 0;
    (void)hipGetDevice(&dev);
    (void)hipDeviceGetAttribute(&cus, hipDeviceAttributeMultiprocessorCount, dev);
    (void)hipOccupancyMaxActiveBlocksPerMultiprocessor(&per_cu, fwd_megakernel, NTHR, 0);
    if (per_cu > 2) per_cu = 2;
    if (per_cu < 1) per_cu = 1;
    grid_blocks = cus * per_cu;
  }
  Params p{};
  const float** pp = (const float**)&p;
  for (int i = 0; i < 26; ++i) pp[i] = (const float*)d_in[i];
  p.out = (float*)d_out;
  p.ws = (char*)d_ws;
  void* args[] = {&p};
  (void)hipMemsetAsync((char*)d_ws + OFF_BAR, 0, 4 * 16384, stream);
  hipError_t e = hipLaunchCooperativeKernel((void*)fwd_megakernel, dim3(grid_blocks), dim3(NTHR), args, 0, stream);
  if (e != hipSuccess) fprintf(stderr, "cooperative launch failed: %s (grid %d)\n", hipGetErrorString(e), grid_blocks);
}
```

```cpp
#include <hip/hip_runtime.h>
#include <hip/hip_cooperative_groups.h>
#include <cstdio>
namespace cg = cooperative_groups;

#define DI __device__ __forceinline__
typedef short bf16x8 __attribute__((ext_vector_type(8)));
typedef short s16x4 __attribute__((ext_vector_type(4)));
typedef float f32x16 __attribute__((ext_vector_type(16)));
typedef unsigned short bf16_t;
typedef unsigned u32x4 __attribute__((ext_vector_type(4)));
#define MFMA(a, b, c) __builtin_amdgcn_mfma_f32_32x32x16_bf16((a), (b), (c), 0, 0, 0)

constexpr int DM = 1024, TCTX = 4096, TLAT = 2048, NT = 6144, PC = 2048, DEPTH = 4;
constexpr int NEXP = 16384;
constexpr float ALPHA = 1.681792830507429f;
constexpr float LN_EPS = 1e-5f;
constexpr int NTHR = 256;

constexpr size_t OUT_Y = 0;
constexpr size_t OUT_WK = 6291456, OUT_WV = 8388608, OUT_DK = 10485760, OUT_DV = 14680064;

constexpr size_t SZ_WINT = (size_t)DEPTH * PC * DM * 2;
constexpr size_t SZ_WSQ = (size_t)DEPTH * DM * DM * 2;
constexpr size_t SZ_TAB = (size_t)DEPTH * NEXP * DM * 2;
constexpr size_t OFF_WINT = 0;
constexpr size_t OFF_WOUTT = OFF_WINT + SZ_WINT;
constexpr size_t OFF_WQT = OFF_WOUTT + SZ_WSQ;
constexpr size_t OFF_UB = OFF_WQT + SZ_WSQ;
constexpr size_t OFF_VB = OFF_UB + SZ_TAB;
constexpr size_t OFF_X = OFF_VB + SZ_TAB;
constexpr size_t OFF_H = OFF_X + (size_t)NT * DM * 4;
constexpr size_t OFF_P = OFF_H + (size_t)NT * DM * 2;
constexpr size_t OFF_O = OFF_P + (size_t)NT * PC * 2;
constexpr size_t OFF_Q = OFF_O + (size_t)NT * DM * 2;
constexpr size_t OFF_MOD = OFF_Q + (size_t)NT * DM * 4;
constexpr size_t OFF_MODP = OFF_MOD + (size_t)DEPTH * 3 * 6144 * 4;
constexpr size_t OFF_ROPEB = OFF_MODP + (size_t)DEPTH * 16 * 3 * 6144 * 4;
constexpr size_t OFF_ROPEC = OFF_ROPEB + (size_t)1024 * 64 * 2 * 4;
constexpr size_t OFF_LAM = OFF_ROPEC + (size_t)1024 * 32 * 2 * 4;
constexpr size_t OFF_CTR = OFF_LAM + 256;
constexpr size_t OFF_CWKB = OFF_CTR + 1024;
constexpr size_t OFF_CWVB = OFF_CWKB + (size_t)2 * 4 * 256 * 128 * 2;
constexpr size_t OFF_CDKB = OFF_CWVB + (size_t)2 * 4 * 256 * 128 * 2;
constexpr size_t OFF_CDVB = OFF_CDKB + (size_t)2 * 4 * 256 * 256 * 2;
constexpr size_t OFF_USC = OFF_CDVB + (size_t)2 * 4 * 256 * 256 * 2;
constexpr size_t OFF_VSC = OFF_USC + (size_t)DEPTH * NEXP * 4;
constexpr size_t OFF_KEYB = OFF_VSC + (size_t)DEPTH * NEXP * 4;
constexpr size_t OFF_BAR = OFF_KEYB + (size_t)DEPTH * 2 * 128 * 64 * 2; constexpr size_t OFF_BAR_UNUSED = OFF_CDVB + (size_t)2 * 4 * 256 * 256 * 2;
constexpr size_t OFF_X2 = OFF_BAR + 4 * 16384;
constexpr size_t OFF_H2 = OFF_X2 + (size_t)NT * DM * 4;
constexpr size_t OFF_QCTR = OFF_H2 + (size_t)NT * DM * 2;
constexpr int REP_P0 = 1, REP_G1 = 1, REP_MIX = 1, REP_G2 = 1, REP_LN1 = 1, REP_G3 = 1, REP_PEER = 1;
constexpr int SLOT_OFF = 78000;

struct Params {
  const float *x_prompt, *x_sample, *c, *cwk, *cwv, *cdk, *cdv, *c_ctx, *w_mod, *b_mod, *w_in, *w_out, *chunk_w, *chunk_b,
      *win_sink, *lam_q, *lam_k, *subln_g, *pool_w, *pool_scale, *ln_g, *ln_b, *peer_wq, *peer_keys, *peer_u, *peer_v;
  float* out;
  char* ws;
};

typedef __bf16 bf2v_t __attribute__((ext_vector_type(2)));
typedef float f2v_t __attribute__((ext_vector_type(2)));
DI unsigned pk2(float a, float b) { f2v_t v = {a, b}; return __builtin_bit_cast(unsigned, __builtin_convertvector(v, bf2v_t)); }
DI unsigned short f2bf(float x) { return (unsigned short)(pk2(x, 0.f) & 0xffffu); }
DI float bflo(unsigned u) { return __uint_as_float(u << 16); }
DI float bfhi(unsigned u) { return __uint_as_float(u & 0xffff0000u); }
DI float gelu_t(float x) { return x / (1.f + __expf(-1.5957691216057308f * (x + 0.044715f * x * x * x))); }
DI float wave_sum(float v) {
#pragma unroll
  for (int o = 32; o; o >>= 1) v += __shfl_xor(v, o);
  return v;
}
typedef __bf16 bf2_t __attribute__((ext_vector_type(2)));
DI float dot2bf(unsigned a, unsigned b, float c) { return __builtin_amdgcn_fdot2_f32_bf16(__builtin_bit_cast(bf2_t, a), __builtin_bit_cast(bf2_t, b), c, false); }
typedef float f32x4nt_t __attribute__((ext_vector_type(4)));
DI float4 ld_nt4(const float* p) { const f32x4nt_t t = __builtin_nontemporal_load((const f32x4nt_t*)p); return make_float4(t[0], t[1], t[2], t[3]); }
DI int opaque_tid() { int t = threadIdx.x; asm volatile("" : "+v"(t)); return t; }
struct Grp { int g, lb, GB, j, lq, QB; };
DI Grp my_grp() { Grp r; r.GB = (int)gridDim.x >> 1; r.g = (int)blockIdx.x & 1; r.lb = (int)blockIdx.x >> 1; r.j = r.lb & 3; r.lq = r.lb >> 2; r.QB = r.GB >> 2; return r; }
DI int mtile_g(int g, int mt) { return mt < 16 ? g * 16 + mt : 32 + g * 8 + (mt - 16); }
DI int tok_g(int g, int u) { return u < 2048 ? g * 2048 + u : TCTX + g * 1024 + (u - 2048); }
constexpr int GTOK = 3072;
constexpr int QTOK = 768;
constexpr bool SPLIT_OFFSET = true;
DI int next_tile_q(const Grp& gr, int* ctrq, char* smem, bool& first) {
  int* slot = (int*)(smem + SLOT_OFF);
  if (first) { first = false; return gr.lq; }
  __syncthreads();
  if (threadIdx.x == 0) *slot = gr.QB + atomicAdd(ctrq, 1);
  __syncthreads();
  return *slot;
}
DI int next_item(const Grp& gr, int* ctr, char* smem, bool& first, int nshard) {
  int* slot = (int*)(smem + SLOT_OFF);
  if (first) { first = false; return gr.lb; }
  __syncthreads();
  if (threadIdx.x == 0) {
    const int q = (nshard == 8) ? (gr.lb & 7) : 0;
    *slot = gr.GB + q + nshard * atomicAdd(ctr + q * 64, 1);
  }
  __syncthreads();
  return *slot;
}
DI int crow(int reg, int h) { return (reg & 3) + 8 * (reg >> 2) + 4 * h; }
DI uint4 pack8(const float* v) {
  uint4 r;
  r.x = pk2(v[0], v[1]); r.y = pk2(v[2], v[3]); r.z = pk2(v[4], v[5]); r.w = pk2(v[6], v[7]);
  return r;
}
DI bf16x8 as_bf16x8(uint4 u) { return __builtin_bit_cast(bf16x8, u); }

DI void load_row(const float* p, int lane, float (&v)[16]) {
#pragma unroll
  for (int c = 0; c < 2; ++c) {
    float4 a = *(const float4*)(p + c * 512 + lane * 8);
    float4 b = *(const float4*)(p + c * 512 + lane * 8 + 4);
    v[c * 8 + 0] = a.x; v[c * 8 + 1] = a.y; v[c * 8 + 2] = a.z; v[c * 8 + 3] = a.w;
    v[c * 8 + 4] = b.x; v[c * 8 + 5] = b.y; v[c * 8 + 6] = b.z; v[c * 8 + 7] = b.w;
  }
}
DI void store_row(float* p, int lane, const float (&v)[16]) {
#pragma unroll
  for (int c = 0; c < 2; ++c) {
    *(float4*)(p + c * 512 + lane * 8) = make_float4(v[c * 8 + 0], v[c * 8 + 1], v[c * 8 + 2], v[c * 8 + 3]);
    *(float4*)(p + c * 512 + lane * 8 + 4) = make_float4(v[c * 8 + 4], v[c * 8 + 5], v[c * 8 + 6], v[c * 8 + 7]);
  }
}
DI void store_row_bf(bf16_t* p, int lane, const float (&v)[16]) {
#pragma unroll
  for (int c = 0; c < 2; ++c) *(uint4*)(p + c * 512 + lane * 8) = pack8(&v[c * 8]);
}
DI void load_row16(const float* p, int lane, float (&v)[16]) {
#pragma unroll
  for (int j = 0; j < 4; ++j) {
    float4 a = *(const float4*)(p + j * 256 + lane * 4);
    v[4 * j] = a.x; v[4 * j + 1] = a.y; v[4 * j + 2] = a.z; v[4 * j + 3] = a.w;
  }
}
DI void store_row16(float* p, int lane, const float (&v)[16]) {
#pragma unroll
  for (int j = 0; j < 4; ++j) *(float4*)(p + j * 256 + lane * 4) = make_float4(v[4 * j], v[4 * j + 1], v[4 * j + 2], v[4 * j + 3]);
}
DI void ln_stats(const float (&v)[16], float& mu, float& rstd) {
  float s = 0.f;
#pragma unroll
  for (int i = 0; i < 16; ++i) s += v[i];
  s = wave_sum(s);
  mu = s * (1.f / 1024.f);
  float q = 0.f;
#pragma unroll
  for (int i = 0; i < 16; ++i) { float d = v[i] - mu; q += d * d; }
  q = wave_sum(q);
  rstd = rsqrtf(q * (1.f / 1024.f) + LN_EPS);
}
DI int tok_grp(int t) { return t < TCTX ? 0 : 1 + ((t - TCTX) >> 10); }
DI void ln_mod_to_bf(const float (&v)[16], const float* modv, int shoff, bf16_t* dst, int lane) {
  float mu, rstd;
  ln_stats(v, mu, rstd);
  float sh[16], sc[16], h[16];
  load_row(modv + shoff, lane, sh);
  load_row(modv + shoff + 1024, lane, sc);
#pragma unroll
  for (int i = 0; i < 16; ++i) h[i] = (v[i] - mu) * rstd * (1.f + sc[i]) + sh[i];
  store_row_bf(dst, lane, h);
}

DI void convert_tables(const Params& p, int r0, int r1, int gw, int nw) {
  char* ws = p.ws;
  const int lane = opaque_tid() & 63;
  const int nrow = r1 - r0;
  for (int bi = gw * 4; bi < 2 * nrow; bi += nw * 4) {
    const int tb = bi >= nrow ? 1 : 0;
    const int row = r0 + (bi - tb * nrow);
    const float* src = (tb ? p.peer_v : p.peer_u) + ((size_t)row << 10) + lane * 4;
    unsigned char* dst = (unsigned char*)(ws + OFF_UB) + ((size_t)row << 11) + tb * 1024 + lane * 16;
    float* sc = (float*)(ws + (tb ? OFF_VSC : OFF_USC)) + row;
    float4 x[4][4];
#pragma unroll
    for (int rr = 0; rr < 4; ++rr)
#pragma unroll
      for (int j = 0; j < 4; ++j) x[rr][j] = ld_nt4(src + (size_t)rr * 1024 + j * 256);
#pragma unroll
    for (int rr = 0; rr < 4; ++rr) {
      float am = 0.f;
#pragma unroll
      for (int j = 0; j < 4; ++j) am = fmaxf(am, fmaxf(fmaxf(fabsf(x[rr][j].x), fabsf(x[rr][j].y)), fmaxf(fabsf(x[rr][j].z), fabsf(x[rr][j].w))));
#pragma unroll
      for (int o = 32; o; o >>= 1) am = fmaxf(am, __shfl_xor(am, o));
      const float scale = am > 0.f ? 256.f / am : 1.f;
      u32x4 q;
#pragma unroll
      for (int j = 0; j < 4; ++j) {
        int w = __builtin_amdgcn_cvt_pk_fp8_f32(x[rr][j].x * scale, x[rr][j].y * scale, 0, false);
        w = __builtin_amdgcn_cvt_pk_fp8_f32(x[rr][j].z * scale, x[rr][j].w * scale, w, true);
        q[j] = (unsigned)w;
      }
      *(u32x4*)(dst + (size_t)rr * 2048) = q;
      if (lane == 0) sc[rr] = am > 0.f ? am * (1.f / 256.f) : 1.f;
    }
  }
}

DI void transpose_tile(const float* src, bf16_t* dst, int K, int N, int k0, int n0, float* tile  ) {
  const int tid = threadIdx.x;
#pragma unroll
  for (int i = 0; i < 4; ++i) {
    const int row = i * 16 + (tid >> 4), c4 = (tid & 15) * 4;
    const float4 v = ld_nt4(src + (size_t)(k0 + row) * N + n0 + c4);
    tile[row * 65 + c4] = v.x; tile[row * 65 + c4 + 1] = v.y; tile[row * 65 + c4 + 2] = v.z; tile[row * 65 + c4 + 3] = v.w;
  }
  __syncthreads();
#pragma unroll
  for (int i = 0; i < 2; ++i) {
    const int nrow = i * 32 + (tid >> 3), kc = (tid & 7) * 8;
    float f[8];
#pragma unroll
    for (int k = 0; k < 8; ++k) f[k] = tile[(kc + k) * 65 + nrow];
    *(uint4*)(dst + (size_t)(n0 + nrow) * K + k0 + kc) = pack8(f);
  }
  __syncthreads();
}

DI void phase0(const Params& p, char* smem) {
  const int tid = threadIdx.x;
  const int gthreads = gridDim.x * NTHR;
  const int gtid = blockIdx.x * NTHR + tid;
  char* ws = p.ws;
  for (int it = blockIdx.x; it < DEPTH * 1024; it += gridDim.x) {
    int l = it >> 10, r = it & 1023;
    if (r < 512) {
      int kt = r >> 5, nt = r & 31;
      transpose_tile(p.w_in + (size_t)l * DM * PC, (bf16_t*)(ws + OFF_WINT) + (size_t)l * PC * DM, DM, PC, kt * 64, nt * 64, (float*)smem);
    } else if (r < 768) {
      int q = r - 512, kt = q >> 4, nt = q & 15;
      transpose_tile(p.w_out + (size_t)l * DM * DM, (bf16_t*)(ws + OFF_WOUTT) + (size_t)l * DM * DM, DM, DM, kt * 64, nt * 64, (float*)smem);
    } else {
      int q = r - 768, kt = q >> 4, nt = q & 15;
      transpose_tile(p.peer_wq + (size_t)l * DM * DM, (bf16_t*)(ws + OFF_WQT) + (size_t)l * DM * DM, DM, DM, kt * 64, nt * 64, (float*)smem);
    }
  }
  {
    float* sv = (float*)smem;
    float* red = sv + 3 * 1024;
    for (int i = tid; i < 3 * 1024; i += NTHR) {
      int v = i >> 10, k = i & 1023;
      float x = (v == 0) ? p.c_ctx[k] : p.c[(v - 1) * 1024 + k];
      sv[i] = x / (1.f + __expf(-x));
    }
    __syncthreads();
    const int wave = tid >> 6, lane = tid & 63;
    float* modp = (float*)(ws + OFF_MODP);
    for (int it = blockIdx.x; it < DEPTH * 24 * 16; it += gridDim.x) {
      int l = it / 384, r = it % 384, nb = r >> 4, ks = r & 15;
      int kbase = ks * 64 + wave * 16;
      const float* wp = p.w_mod + ((size_t)l * DM + kbase) * 6144 + nb * 256 + lane * 4;
      float4 w[16];
#pragma unroll
      for (int k = 0; k < 16; ++k) w[k] = ld_nt4(wp + (size_t)k * 6144);
      float a[3][4];
#pragma unroll
      for (int v = 0; v < 3; ++v) { a[v][0] = a[v][1] = a[v][2] = a[v][3] = 0.f; }
#pragma unroll
      for (int k = 0; k < 16; ++k) {
#pragma unroll
        for (int v = 0; v < 3; ++v) {
          float s = sv[v * 1024 + kbase + k];
          a[v][0] += s * w[k].x; a[v][1] += s * w[k].y; a[v][2] += s * w[k].z; a[v][3] += s * w[k].w;
        }
      }
#pragma unroll
      for (int v = 0; v < 3; ++v)
        *(float4*)&red[(wave * 3 + v) * 256 + lane * 4] = make_float4(a[v][0], a[v][1], a[v][2], a[v][3]);
      __syncthreads();
      for (int i = tid; i < 768; i += NTHR) {
        int v = i >> 8, cidx = i & 255;
        float s = red[(0 * 3 + v) * 256 + cidx] + red[(1 * 3 + v) * 256 + cidx] + red[(2 * 3 + v) * 256 + cidx] + red[(3 * 3 + v) * 256 + cidx];
        modp[(((size_t)l * 16 + ks) * 3 + v) * 6144 + nb * 256 + cidx] = s;
      }
      __syncthreads();
    }
  }
  convert_tables(p, 0, (SPLIT_OFFSET ? 2 : 4) * NEXP, blockIdx.x * 4 + (tid >> 6), gridDim.x * 4);
  {
    const int n1 = 2 * 4 * 256 * 128 / 8, n2 = 2 * 4 * 256 * 256 / 8;
    for (int i = gtid; i < 2 * n1 + 2 * n2; i += gthreads) {
      const float* src; uint4* dst; int j;
      if (i < n1) { src = p.cwk; dst = (uint4*)(ws + OFF_CWKB); j = i; }
      else if (i < 2 * n1) { src = p.cwv; dst = (uint4*)(ws + OFF_CWVB); j = i - n1; }
      else if (i < 2 * n1 + n2) { src = p.cdk; dst = (uint4*)(ws + OFF_CDKB); j = i - 2 * n1; }
      else { src = p.cdv; dst = (uint4*)(ws + OFF_CDVB); j = i - 2 * n1 - n2; }
      float4 a = ((const float4*)src)[2 * j], bb = ((const float4*)src)[2 * j + 1];
      uint4 rr; rr.x = pk2(a.x, a.y); rr.y = pk2(a.z, a.w); rr.z = pk2(bb.x, bb.y); rr.w = pk2(bb.z, bb.w);
      dst[j] = rr;
    }
  }
  for (int i = gtid; i < DEPTH * 2 * 128 * 64 / 8; i += gthreads) {
    float4 a = ((const float4*)p.peer_keys)[2 * i], bb = ((const float4*)p.peer_keys)[2 * i + 1];
    uint4 rr; rr.x = pk2(a.x, a.y); rr.y = pk2(a.z, a.w); rr.z = pk2(bb.x, bb.y); rr.w = pk2(bb.z, bb.w);
    ((uint4*)(ws + OFF_KEYB))[i] = rr;
  }
  {
    float* rb = (float*)(ws + OFF_ROPEB);
    float* rc = (float*)(ws + OFF_ROPEC);
    for (int i = gtid; i < 1024 * 64; i += gthreads) {
      int pos = i >> 6, d = i & 63;
      float pv = (d < 32) ? (float)(pos >> 6) : (float)(pos & 63);
      float inv = powf(10000.f, -(float)(d & 15) / 16.f);
      float ang = pv * inv;
      rb[i] = cosf(ang);
      rb[1024 * 64 + i] = sinf(ang);
    }
    for (int i = gtid; i < 1024 * 32; i += gthreads) {
      int pos = i >> 5, d = i & 31;
      float pv = (d < 16) ? (float)(pos >> 6) : (float)(pos & 63);
      float inv = powf(10000.f, -(float)(d & 7) / 8.f);
      float ang = pv * inv;
      rc[i] = cosf(ang);
      rc[1024 * 32 + i] = sinf(ang);
    }
  }
  if (blockIdx.x == 0) { for (int i = tid; i < 2 * 32 * 512; i += NTHR) ((int*)(ws + OFF_QCTR))[i] = 0; }
  if (blockIdx.x == 0 && tid < DEPTH) {
    int l = tid;
    float s0 = 0.f, s1 = 0.f;
    for (int i = 0; i < 32; ++i) {
      s0 += p.lam_q[l * 64 + i] * p.lam_k[l * 64 + i];
      s1 += p.lam_q[l * 64 + 32 + i] * p.lam_k[l * 64 + 32 + i];
    }
    float lam_init = 0.8f - 0.6f * expf(-0.3f * (float)l);
    ((float*)(ws + OFF_LAM))[l] = expf(s0) - expf(s1) + lam_init;
    ((float*)(ws + OFF_LAM))[4 + l] = lam_init;
  }
}

DI void phase_modreduce(const Params& p) {
  const int gthreads = gridDim.x * NTHR;
  const int gtid = blockIdx.x * NTHR + threadIdx.x;
  const float* modp = (const float*)(p.ws + OFF_MODP);
  float* mod = (float*)(p.ws + OFF_MOD);
  for (int i = gtid; i < DEPTH * 3 * 6144; i += gthreads) {
    int l = i / (3 * 6144), r = i % (3 * 6144), n = r % 6144;
    float s = p.b_mod[l * 6144 + n];
#pragma unroll
    for (int ks = 0; ks < 16; ++ks) s += modp[((size_t)l * 16 + ks) * 3 * 6144 + r];
    mod[i] = s;
  }
}

DI void phase_ln0(const Params& p) {
  const int lane = threadIdx.x & 63;
  const int gw = blockIdx.x * 4 + (threadIdx.x >> 6), nw = gridDim.x * 4;
  float* X = (float*)(p.ws + OFF_X);
  bf16_t* H = (bf16_t*)(p.ws + OFF_H);
  const float* mod = (const float*)(p.ws + OFF_MOD);
  for (int t = gw; t < NT; t += nw) {
    const float* src = t < TCTX ? p.x_prompt + (size_t)t * DM : p.x_sample + (size_t)(t - TCTX) * DM;
    float v[16];
    load_row(src, lane, v);
    store_row(X + (size_t)t * DM, lane, v);
    ln_mod_to_bf(v, mod + (size_t)(0 * 3 + tok_grp(t)) * 6144, 0, H + (size_t)t * DM, lane);
  }
}

DI void phase_ln1(const Grp& gr, const Params& p, int l, bool dry) {
  const int tid = opaque_tid();
  const int lane = tid & 63;
  const int gw = gr.lq * 4 + (tid >> 6), nw = gr.QB * 4;
  const float* X = (const float*)(p.ws + OFF_X);
  float* Xo = (float*)(p.ws + (dry ? OFF_X2 : OFF_X));
  bf16_t* H = (bf16_t*)(p.ws + (dry ? OFF_H2 : OFF_H));
  const float* mod = (const float*)(p.ws + OFF_MOD);
  for (int uq = gw; uq < QTOK; uq += nw) {
    const int t = tok_g(gr.g, gr.j * QTOK + uq);
    float v[16], g[16], b[16];
    load_row(X + (size_t)t * DM, lane, v);
    load_row(p.ln_g + (size_t)(l * 2 + 0) * DM, lane, g);
    load_row(p.ln_b + (size_t)(l * 2 + 0) * DM, lane, b);
    float mu, rstd;
    ln_stats(v, mu, rstd);
#pragma unroll
    for (int i = 0; i < 16; ++i) v[i] = (v[i] - mu) * rstd * g[i] + b[i];
    store_row(Xo + (size_t)t * DM, lane, v);
    ln_mod_to_bf(v, mod + (size_t)(l * 3 + tok_grp(t)) * 6144, 3072, H + (size_t)t * DM, lane);
  }
}

constexpr int GSTR = 72;
template <class Epi>
DI void gemm_phase(const Grp& gr, int nshard, const bf16_t* __restrict__ A, const bf16_t* __restrict__ Bt, int N, char* smem, int* ctr, Epi epi) {
  const int tid = opaque_tid(), lane = tid & 63, wave = tid >> 6;
  const int r = lane & 31, h = lane >> 5;
  const int wm = wave >> 1, wn = wave & 1;
  bf16_t* As = (bf16_t*)smem;
  bf16_t* Bs = As + 2 * 128 * GSTR;
  const int tiles_n = N >> 7;
  const int ntiles = 6 * tiles_n;
  bool qfirst = true;
  for (;;) {
    const int tile = next_tile_q(gr, ctr + gr.j * 64, smem, qfirst);
    if (tile >= ntiles) break;
    const int tn = tile % tiles_n, tm = mtile_g(gr.g, gr.j * 6 + tile / tiles_n);
    const int m0 = tm * 128, n0 = tn * 128;
    const bf16_t* Ap = A + (size_t)m0 * DM;
    const bf16_t* Bp = Bt + (size_t)n0 * DM;
    f32x16 acc[2][2];
#pragma unroll
    for (int i = 0; i < 2; ++i)
#pragma unroll
      for (int j = 0; j < 2; ++j)
#pragma unroll
        for (int e = 0; e < 16; ++e) acc[i][j][e] = 0.f;
    u32x4 ra0[4], rb0[4], ra1[4], rb1[4];
    const bf16_t* Ag = Ap + (size_t)(tid >> 3) * DM + (tid & 7) * 8;
    const bf16_t* Bg = Bp + (size_t)(tid >> 3) * DM + (tid & 7) * 8;
    const int lofs = (tid >> 3) * GSTR + (tid & 7) * 8;
#define G_LOAD(RA, RB, KT) { _Pragma("unroll") for (int i = 0; i < 4; ++i) { \
      RA[i] = *(const u32x4*)(Ag + (size_t)i * 32 * DM + (KT) * 64); RB[i] = *(const u32x4*)(Bg + (size_t)i * 32 * DM + (KT) * 64); } }
#define G_STORE(RA, RB, BUF) { _Pragma("unroll") for (int i = 0; i < 4; ++i) { \
      *(u32x4*)(As + (BUF) * 128 * GSTR + lofs + i * 32 * GSTR) = RA[i]; *(u32x4*)(Bs + (BUF) * 128 * GSTR + lofs + i * 32 * GSTR) = RB[i]; } }
#define G_FRAGS(SET, Ac, Bc, KS) { \
        fa0[SET] = *(const bf16x8*)(Ac + (wm * 64 + r) * GSTR + (KS) * 16 + h * 8); \
        fa1[SET] = *(const bf16x8*)(Ac + (wm * 64 + 32 + r) * GSTR + (KS) * 16 + h * 8); \
        fb0[SET] = *(const bf16x8*)(Bc + (wn * 64 + r) * GSTR + (KS) * 16 + h * 8); \
        fb1[SET] = *(const bf16x8*)(Bc + (wn * 64 + 32 + r) * GSTR + (KS) * 16 + h * 8); }
#define G_MFMAS(SET) { \
        acc[0][0] = MFMA(fa0[SET], fb0[SET], acc[0][0]); acc[0][1] = MFMA(fa0[SET], fb1[SET], acc[0][1]); \
        acc[1][0] = MFMA(fa1[SET], fb0[SET], acc[1][0]); acc[1][1] = MFMA(fa1[SET], fb1[SET], acc[1][1]); }
#define G_COMPUTE(BUF) { const bf16_t* Ac = As + (BUF) * 128 * GSTR; const bf16_t* Bc = Bs + (BUF) * 128 * GSTR; \
      bf16x8 fa0[2], fa1[2], fb0[2], fb1[2]; \
      G_FRAGS(0, Ac, Bc, 0); \
      __builtin_amdgcn_sched_barrier(0); \
      G_FRAGS(1, Ac, Bc, 1); \
      __builtin_amdgcn_sched_barrier(0); \
      G_MFMAS(0); \
      __builtin_amdgcn_sched_barrier(0); \
      G_FRAGS(0, Ac, Bc, 2); \
      __builtin_amdgcn_sched_barrier(0); \
      G_MFMAS(1); \
      __builtin_amdgcn_sched_barrier(0); \
      G_FRAGS(1, Ac, Bc, 3); \
      __builtin_amdgcn_sched_barrier(0); \
      G_MFMAS(0); \
      __builtin_amdgcn_sched_barrier(0); \
      G_MFMAS(1); \
      __builtin_amdgcn_sched_barrier(0); }
    G_LOAD(ra0, rb0, 0);
    G_LOAD(ra1, rb1, 1);
    G_STORE(ra0, rb0, 0);
    __syncthreads();
#pragma unroll 1
    for (int kt = 0; kt < 16; kt += 2) {
      if (kt + 2 < 16) G_LOAD(ra0, rb0, kt + 2);
      G_COMPUTE(0);
      G_STORE(ra1, rb1, 1);
      __syncthreads();
      if (kt + 3 < 16) G_LOAD(ra1, rb1, kt + 3);
      G_COMPUTE(1);
      if (kt + 2 < 16) G_STORE(ra0, rb0, 0);
      __syncthreads();
    }
#undef G_LOAD
#undef G_STORE
#undef G_COMPUTE
#undef G_FRAGS
#undef G_MFMAS
#pragma unroll
    for (int i = 0; i < 2; ++i)
#pragma unroll
      for (int j = 0; j < 2; ++j) epi(m0 + wm * 64 + i * 32, n0 + wn * 64 + j * 32, acc[i][j], r, h);
  }
}

constexpr int KSTR = 72;
constexpr int VSTR = 136;

struct AttnState { f32x16 o[2]; float m, l; };

DI void stage_k_bf(bf16_t* Ks, const bf16_t* src) {
  int tid = threadIdx.x;
  asm volatile("" : "+v"(tid));
#pragma unroll
  for (int i = 0; i < 4; ++i) {
    int id = tid + 256 * i, row = id >> 3, ch = id & 7;
    *(uint4*)(Ks + row * KSTR + ch * 8) = *(const uint4*)(src + (size_t)row * PC + ch * 8);
  }
}
DI void stage_k_f32(bf16_t* Ks, const float* src, int rstride) {
  int tid = threadIdx.x;
  asm volatile("" : "+v"(tid));
#pragma unroll
  for (int i = 0; i < 4; ++i) {
    int id = tid + 256 * i, row = id >> 3, ch = id & 7;
    const float* s = src + (size_t)row * rstride + ch * 8;
    float4 a = *(const float4*)s, b = *(const float4*)(s + 4);
    uint4 r; r.x = pk2(a.x, a.y); r.y = pk2(a.z, a.w); r.z = pk2(b.x, b.y); r.w = pk2(b.z, b.w);
    *(uint4*)(Ks + row * KSTR + ch * 8) = r;
  }
}
DI void stage_vt_bf(bf16_t* Vt, const bf16_t* src) {
  int tid = threadIdx.x;
  asm volatile("" : "+v"(tid));
#pragma unroll
  for (int i = 0; i < 4; ++i) {
    int id = tid + 256 * i, row = id & 127, ch = id >> 7;
    uint4 v = *(const uint4*)(src + (size_t)row * PC + ch * 8);
    unsigned w[4] = {v.x, v.y, v.z, v.w};
#pragma unroll
    for (int k = 0; k < 4; ++k) {
      Vt[(ch * 8 + 2 * k) * VSTR + row] = (bf16_t)(w[k] & 0xffffu);
      Vt[(ch * 8 + 2 * k + 1) * VSTR + row] = (bf16_t)(w[k] >> 16);
    }
  }
}
DI void stage_vt_f32(bf16_t* Vt, const float* src, int rstride) {
  int tid = threadIdx.x;
  asm volatile("" : "+v"(tid));
#pragma unroll
  for (int i = 0; i < 4; ++i) {
    int id = tid + 256 * i, row = id & 127, ch = id >> 7;
    const float* s = src + (size_t)row * rstride + ch * 8;
    float4 a = *(const float4*)s, b = *(const float4*)(s + 4);
    float f[8] = {a.x, a.y, a.z, a.w, b.x, b.y, b.z, b.w};
#pragma unroll
    for (int k = 0; k < 8; ++k) Vt[(ch * 8 + k) * VSTR + row] = f2bf(f[k]);
  }
}

template <int NKS>
DI void attn_tile(const bf16_t* Ks, int kcol0, const bf16_t* Vt, const bf16x8 (&qf)[NKS], AttnState& st, float cscale,
                  int maskmode, int qpos, int kpos0, int r, int h) {
  f32x16 s[2];
#pragma unroll
  for (int kb = 0; kb < 2; ++kb) {
#pragma unroll
    for (int e = 0; e < 16; ++e) s[kb][e] = 0.f;
#pragma unroll
    for (int ks = 0; ks < NKS; ++ks) {
      bf16x8 a = *(const bf16x8*)(Ks + (kb * 32 + r) * KSTR + kcol0 + ks * 16 + h * 8);
      s[kb] = MFMA(a, qf[ks], s[kb]);
    }
  }
  float tmax = -INFINITY;
#pragma unroll
  for (int kb = 0; kb < 2; ++kb)
#pragma unroll
    for (int e = 0; e < 16; ++e) {
      float v = s[kb][e] * cscale;
      if (maskmode) {
        int kp = kpos0 + kb * 32 + crow(e, h);
        int dd = kp - qpos; dd = dd < 0 ? -dd : dd;
        v = (dd <= 128) ? v : -INFINITY;
      }
      s[kb][e] = v;
      tmax = fmaxf(tmax, v);
    }
  tmax = fmaxf(tmax, __shfl_xor(tmax, 32));
  float mnew = fmaxf(st.m, tmax);
  float alpha = (mnew == -INFINITY) ? 1.f : __builtin_amdgcn_exp2f(st.m - mnew);
  float msub = (mnew == -INFINITY) ? 0.f : mnew;
  float psum = 0.f;
#pragma unroll
  for (int kb = 0; kb < 2; ++kb)
#pragma unroll
    for (int e = 0; e < 16; ++e) {
      float pv = __builtin_amdgcn_exp2f(s[kb][e] - msub);
      s[kb][e] = pv;
      psum += pv;
    }
  st.l = st.l * alpha + psum;
  st.m = mnew;
#pragma unroll
  for (int db = 0; db < 2; ++db)
#pragma unroll
    for (int e = 0; e < 16; ++e) st.o[db][e] *= alpha;
#pragma unroll
  for (int kb = 0; kb < 2; ++kb)
#pragma unroll
    for (int ss = 0; ss < 2; ++ss) {
      uint4 pu;
      pu.x = pk2(s[kb][8 * ss + 0], s[kb][8 * ss + 1]);
      pu.y = pk2(s[kb][8 * ss + 2], s[kb][8 * ss + 3]);
      pu.z = pk2(s[kb][8 * ss + 4], s[kb][8 * ss + 5]);
      pu.w = pk2(s[kb][8 * ss + 6], s[kb][8 * ss + 7]);
      bf16x8 pb = as_bf16x8(pu);
#pragma unroll
      for (int db = 0; db < 2; ++db) {
        const bf16_t* vp = Vt + (db * 32 + r) * VSTR + kb * 32 + 16 * ss + 4 * h;
        s16x4 lo = *(const s16x4*)vp;
        s16x4 hi = *(const s16x4*)(vp + 8);
        bf16x8 va = __builtin_shufflevector(lo, hi, 0, 1, 2, 3, 4, 5, 6, 7);
        st.o[db] = MFMA(va, pb, st.o[db]);
      }
    }
}

DI void store_oT(bf16_t* O, int token, int colbase, const f32x16 (&o)[2], int h) {
#pragma unroll
  for (int db = 0; db < 2; ++db)
#pragma unroll
    for (int g = 0; g < 4; ++g) {
      uint2 u;
      u.x = pk2(o[db][4 * g + 0], o[db][4 * g + 1]);
      u.y = pk2(o[db][4 * g + 2], o[db][4 * g + 3]);
      *(uint2*)(O + (size_t)token * DM + colbase + db * 32 + 8 * g + 4 * h) = u;
    }
}

DI void attn_init(AttnState& st, float m0, float l0) {
#pragma unroll
  for (int db = 0; db < 2; ++db)
#pragma unroll
    for (int e = 0; e < 16; ++e) st.o[db][e] = 0.f;
  st.m = m0;
  st.l = l0;
}

DI void mixer_bc(const Params& p, int l, bool isC, bool lat, int b, int hd, int qb, char* smem) {
  const int tid = opaque_tid(), lane = tid & 63, wave = tid >> 6, r = lane & 31, h = lane >> 5;
  const int qblk = wave >> 1, role = wave & 1;
  const int hdw = isC ? hd : (hd & ~1) + role;
  bf16_t* Ks = (bf16_t*)smem;
  bf16_t* Vt = Ks + 128 * KSTR;
  float* xch = (float*)smem;
  const bf16_t* P = (const bf16_t*)(p.ws + OFF_P);
  const int kv = hd >> 1;
  const int seq0 = lat ? TCTX + b * 1024 : b * 256;
  const int qpos = qb * 64 + qblk * 32 + r;
  const int qtok = seq0 + qpos;
  const float LOG2E = 1.4426950408889634f;
  bf16x8 qf[4];
  {
    const int qcol = isC ? 1024 + hd * 64 + role * 32 : 512 + hdw * 64;
    const bf16_t* qp = P + (size_t)qtok * PC + qcol + h * 8;
    qf[0] = *(const bf16x8*)(qp);
    qf[1] = *(const bf16x8*)(qp + 16);
    qf[2] = qf[0]; qf[3] = qf[1];
    if (!isC) { qf[2] = *(const bf16x8*)(qp + 32); qf[3] = *(const bf16x8*)(qp + 48); }
  }
  const float cscale = isC ? 0.17677669529663687f * LOG2E : 0.125f * LOG2E;
  AttnState st;
  if (isC) attn_init(st, -INFINITY, 0.f);
  else attn_init(st, p.win_sink[l * 4 + hdw] * LOG2E, (h == 0) ? 1.f : 0.f);
  const int ntile = isC ? (lat ? 10 : 2) : (lat ? 5 : 2);
  const int band0 = (qb >> 1) - 1;
  u32x4 kreg[4], vreg[4];
  auto tile_exists = [&](int ti) -> bool {
    if (!isC && lat && ti < 3) { int kt = band0 + ti; return kt >= 0 && kt < 8; }
    return true;
  };
  auto tile_load = [&](int ti) {
    const bf16_t *kp, *vp; int stride;
    if (isC) {
      if (lat && ti < 2) {
        const size_t off = ((size_t)(b * DEPTH + l) * 256 + ti * 128) * 256 + hd * 64;
        kp = (const bf16_t*)(p.ws + OFF_CDKB) + off; vp = (const bf16_t*)(p.ws + OFF_CDVB) + off; stride = 256;
      } else {
        const int kt = lat ? ti - 2 : ti;
        const bf16_t* base = P + (size_t)(seq0 + kt * 128) * PC;
        kp = base + 1280 + hd * 64; vp = base + 1536 + hd * 64; stride = PC;
      }
    } else {
      if (lat && ti >= 3) {
        const size_t off = ((size_t)(b * DEPTH + l) * 256 + (ti - 3) * 128) * 128 + kv * 64;
        kp = (const bf16_t*)(p.ws + OFF_CWKB) + off; vp = (const bf16_t*)(p.ws + OFF_CWVB) + off; stride = 128;
      } else {
        const int kt = lat ? band0 + ti : ti;
        const bf16_t* base = P + (size_t)(seq0 + kt * 128) * PC;
        kp = base + 768 + kv * 64; vp = base + 896 + kv * 64; stride = PC;
      }
    }
    int t2 = tid;
    asm volatile("" : "+v"(t2));
#pragma unroll
    for (int i = 0; i < 4; ++i) {
      int id = t2 + 256 * i;
      kreg[i] = *(const u32x4*)(kp + (size_t)(id >> 3) * stride + (id & 7) * 8);
      vreg[i] = *(const u32x4*)(vp + (size_t)(id & 127) * stride + (id >> 7) * 8);
    }
  };
  auto tile_store = [&]() {
    int t2 = tid;
    asm volatile("" : "+v"(t2));
#pragma unroll
    for (int i = 0; i < 4; ++i) {
      int id = t2 + 256 * i;
      *(u32x4*)(Ks + (id >> 3) * KSTR + (id & 7) * 8) = kreg[i];
      const int row = id & 127, ch = id >> 7;
#pragma unroll
      for (int k = 0; k < 4; ++k) {
        Vt[(ch * 8 + 2 * k) * VSTR + row] = (bf16_t)(vreg[i][k] & 0xffffu);
        Vt[(ch * 8 + 2 * k + 1) * VSTR + row] = (bf16_t)(vreg[i][k] >> 16);
      }
    }
  };
  if (tile_exists(0)) tile_load(0);
#pragma unroll 1
  for (int ti = 0; ti < ntile; ++ti) {
    const bool ex = tile_exists(ti);
    __syncthreads();
    if (ex) tile_store();
    __syncthreads();
    if (ti + 1 < ntile && tile_exists(ti + 1)) tile_load(ti + 1);
    if (ex) {
      if (isC) {
        const bf16x8 q2[2] = {qf[0], qf[1]};
#pragma unroll 1
        for (int hf = 0; hf < 2; ++hf)
          attn_tile<2>(Ks + hf * 64 * KSTR, role * 32, Vt + hf * 64, q2, st, cscale, 0, 0, 0, r, h);
      } else {
        const bool band = lat && ti < 3;
#pragma unroll 1
        for (int hf = 0; hf < 2; ++hf)
          attn_tile<4>(Ks + hf * 64 * KSTR, 0, Vt + hf * 64, qf, st, cscale, band ? 1 : 0, qpos, (band0 + ti) * 128 + hf * 64, r, h);
      }
    }
  }
  if (!isC) {
    const float inv = 1.f / (st.l + __shfl_xor(st.l, 32));
#pragma unroll
    for (int db = 0; db < 2; ++db)
#pragma unroll
      for (int e = 0; e < 16; ++e) st.o[db][e] *= inv;
    store_oT((bf16_t*)(p.ws + OFF_O), qtok, 256 + hdw * 64, st.o, h);
    return;
  }
  __syncthreads();
  float* xp = xch + (size_t)(qblk * 64 + lane) * 36;
  if (role == 1) {
#pragma unroll
    for (int db = 0; db < 2; ++db)
#pragma unroll
      for (int g = 0; g < 4; ++g)
        *(float4*)(xp + db * 16 + g * 4) = make_float4(st.o[db][4 * g], st.o[db][4 * g + 1], st.o[db][4 * g + 2], st.o[db][4 * g + 3]);
    xp[32] = st.m; xp[33] = st.l;
  }
  __syncthreads();
  if (role == 0) {
    f32x16 o1[2];
#pragma unroll
    for (int db = 0; db < 2; ++db)
#pragma unroll
      for (int g = 0; g < 4; ++g) {
        float4 v = *(const float4*)(xp + db * 16 + g * 4);
        o1[db][4 * g] = v.x; o1[db][4 * g + 1] = v.y; o1[db][4 * g + 2] = v.z; o1[db][4 * g + 3] = v.w;
      }
    const float m1 = xp[32], l1 = xp[33];
    if (isC) {
      const float lam = ((const float*)(p.ws + OFF_LAM))[l];
      const float lam_init = ((const float*)(p.ws + OFF_LAM))[4 + l];
      float i0 = 1.f / (st.l + __shfl_xor(st.l, 32));
      float i1 = lam / (l1 + __shfl_xor(l1, 32));
      float ss = 0.f;
#pragma unroll
      for (int db = 0; db < 2; ++db)
#pragma unroll
        for (int e = 0; e < 16; ++e) {
          float w = st.o[db][e] * i0 - o1[db][e] * i1;
          st.o[db][e] = w;
          ss += w * w;
        }
      ss += __shfl_xor(ss, 32);
      float rs = rsqrtf(ss * (1.f / 64.f) + LN_EPS) * (1.f - lam_init);
#pragma unroll
      for (int db = 0; db < 2; ++db)
#pragma unroll
        for (int e = 0; e < 16; ++e) st.o[db][e] *= rs * p.subln_g[l * 64 + db * 32 + crow(e, h)];
      store_oT((bf16_t*)(p.ws + OFF_O), qtok, 512 + hd * 64, st.o, h);
    } else {
      const float m = fmaxf(st.m, m1);
      const float a0 = __builtin_amdgcn_exp2f(st.m - m), a1 = __builtin_amdgcn_exp2f(m1 - m);
      float lt = st.l * a0 + l1 * a1;
      lt += __shfl_xor(lt, 32);
      const float inv = 1.f / lt;
      const float c0 = a0 * inv, c1 = a1 * inv;
#pragma unroll
      for (int db = 0; db < 2; ++db)
#pragma unroll
        for (int e = 0; e < 16; ++e) st.o[db][e] = st.o[db][e] * c0 + o1[db][e] * c1;
      store_oT((bf16_t*)(p.ws + OFF_O), qtok, 256 + hd * 64, st.o, h);
    }
  }
}

DI void mixer_a(const Params& p, int l, int ch, int hd, char* smem) {
  const int tid = opaque_tid(), lane = tid & 63, wave = tid >> 6, r = lane & 31, h = lane >> 5;
  bf16_t* Vt = (bf16_t*)smem;
  const bf16_t* P = (const bf16_t*)(p.ws + OFF_P);
  const int tok0 = ch * 128;
  __syncthreads();
  stage_vt_bf(Vt, P + (size_t)tok0 * PC + 256 + hd * 64);
  __syncthreads();
  const int pp = wave * 32 + r;
  const float* wrow = p.chunk_w + ((size_t)(l * 4 + hd) * 128 + pp) * 128;
  f32x16 acc[2];
#pragma unroll
  for (int db = 0; db < 2; ++db)
#pragma unroll
    for (int e = 0; e < 16; ++e) acc[db][e] = 0.f;
#pragma unroll
  for (int ks = 0; ks < 8; ++ks) {
    float4 a = *(const float4*)(wrow + ks * 16 + 8 * h), b = *(const float4*)(wrow + ks * 16 + 8 * h + 4);
    uint4 wu; wu.x = pk2(a.x, a.y); wu.y = pk2(a.z, a.w); wu.z = pk2(b.x, b.y); wu.w = pk2(b.z, b.w);
    bf16x8 wb = as_bf16x8(wu);
#pragma unroll
    for (int db = 0; db < 2; ++db) {
      bf16x8 va = *(const bf16x8*)(Vt + (db * 32 + r) * VSTR + ks * 16 + 8 * h);
      acc[db] = MFMA(va, wb, acc[db]);
    }
  }
  const float bias = p.chunk_b[(l * 4 + hd) * 128 + pp];
  const int token = tok0 + pp;
#pragma unroll
  for (int db = 0; db < 2; ++db)
#pragma unroll
    for (int g = 0; g < 4; ++g) {
      uint2 uu = *(const uint2*)(P + (size_t)token * PC + hd * 64 + db * 32 + 8 * g + 4 * h);
      acc[db][4 * g + 0] = bflo(uu.x) * (acc[db][4 * g + 0] + bias);
      acc[db][4 * g + 1] = bfhi(uu.x) * (acc[db][4 * g + 1] + bias);
      acc[db][4 * g + 2] = bflo(uu.y) * (acc[db][4 * g + 2] + bias);
      acc[db][4 * g + 3] = bfhi(uu.y) * (acc[db][4 * g + 3] + bias);
    }
  store_oT((bf16_t*)(p.ws + OFF_O), token, hd * 64, acc, h);
}

DI void mixer_d(const Params& p, int l, int ch, int g) {
  const int tid = opaque_tid(), lane = tid & 63, wave = tid >> 6, r = lane & 31, h = lane >> 5;
  const bf16_t* P = (const bf16_t*)(p.ws + OFF_P);
  const int token = ch * 128 + wave * 32 + r;
  int s0, slen;
  if (token < TCTX) { s0 = token & ~255; slen = 256; } else { s0 = TCTX + ((token - TCTX) & ~1023); slen = 1024; }
  const int pos = token - s0;
  const int w = 2 << g, hw = w >> 1;
  int lo = pos - hw; if (lo < 0) lo = 0;
  int hi = pos + hw; if (hi > slen) hi = slen;
  const float icnt = 1.f / (float)(hi - lo);
  const float* wp = p.pool_w + (size_t)(l * 4 + g) * 64 * 64;
  f32x16 acc[2];
#pragma unroll
  for (int db = 0; db < 2; ++db)
#pragma unroll
    for (int e = 0; e < 16; ++e) acc[db][e] = 0.f;
#pragma unroll
  for (int ks = 0; ks < 4; ++ks) {
    const int cbase = 1792 + g * 64 + ks * 16 + 8 * h;
    float sum[8];
#pragma unroll
    for (int k = 0; k < 8; ++k) sum[k] = 0.f;
    for (int i = 0; i < w; ++i) {
      int tt = pos - hw + i;
      if (tt >= 0 && tt < slen) {
        uint4 v = *(const uint4*)(P + (size_t)(s0 + tt) * PC + cbase);
        sum[0] += bflo(v.x); sum[1] += bfhi(v.x); sum[2] += bflo(v.y); sum[3] += bfhi(v.y);
        sum[4] += bflo(v.z); sum[5] += bfhi(v.z); sum[6] += bflo(v.w); sum[7] += bfhi(v.w);
      }
    }
    uint4 zv = *(const uint4*)(P + (size_t)token * PC + cbase);
    float z[8] = {bflo(zv.x), bfhi(zv.x), bflo(zv.y), bfhi(zv.y), bflo(zv.z), bfhi(zv.z), bflo(zv.w), bfhi(zv.w)};
    float pl[8];
#pragma unroll
    for (int k = 0; k < 8; ++k) pl[k] = sum[k] * icnt - z[k];
    bf16x8 pb = as_bf16x8(pack8(pl));
#pragma unroll
    for (int db = 0; db < 2; ++db) {
      float wv[8];
#pragma unroll
      for (int k = 0; k < 8; ++k) wv[k] = wp[(ks * 16 + 8 * h + k) * 64 + db * 32 + r];
      bf16x8 wa = as_bf16x8(pack8(wv));
      acc[db] = MFMA(wa, pb, acc[db]);
    }
  }
#pragma unroll
  for (int db = 0; db < 2; ++db)
#pragma unroll
    for (int e = 0; e < 16; ++e) acc[db][e] *= p.pool_scale[l * 256 + g * 64 + db * 32 + crow(e, h)];
  store_oT((bf16_t*)(p.ws + OFF_O), token, 768 + g * 64, acc, h);
}

DI void phase_mixers(const Grp& gr, int nshard, const Params& p, int l, char* smem, int* ctr) {
  bool qfirst = true;
  for (;;) {
    const int it = next_item(gr, ctr, smem, qfirst, nshard);
    if (it >= 480) break;
    if (it < 288) {
      bool lat, cmix; int b, hd, qb;
      if (it < 64) { int q = it; lat = true; cmix = true; b = gr.g; hd = (q >> 4) & 3; qb = q & 15; }
      else if (it < 96) { int q = it - 64; lat = true; cmix = false; b = gr.g; hd = ((q >> 4) & 1) * 2; qb = q & 15; }
      else if (it < 224) { int q = it - 96; lat = false; cmix = true; b = gr.g * 8 + (q >> 4); hd = (q >> 2) & 3; qb = q & 3; }
      else { int q = it - 224; lat = false; cmix = false; b = gr.g * 8 + (q >> 3); hd = ((q >> 2) & 1) * 2; qb = q & 3; }
      mixer_bc(p, l, cmix, lat, b, hd, qb, smem);
    } else if (it < 384) { int q = it - 288; mixer_a(p, l, mtile_g(gr.g, q >> 2), q & 3, smem); }
    else { int q = it - 384; mixer_d(p, l, mtile_g(gr.g, q >> 2), q & 3); }
  }
}

constexpr int PKSTR = 68;
constexpr int PKJ = 128 * PKSTR + 16;

typedef float f32x4 __attribute__((ext_vector_type(4)));
DI void phase_peer(const Grp& gr, const Params& p, int l, char* smem, bool dry) {
  const int tid = opaque_tid(), lane = tid & 63, wave = tid >> 6;
  unsigned* scr3 = (unsigned*)smem + wave * 1024;
  unsigned* eidx = scr3 + 768;
  float* egate = (float*)(scr3 + 896);
  __syncthreads();
  int ci = 0, cj = 0;
  {
    int L = lane, i = 0;
    while (i < 16 && L >= 16 / (i + 1)) { L -= 16 / (i + 1); ++i; }
    ci = i; cj = L;
  }
  const bool cvalid = lane < 50;
  if (!cvalid) { ci = 0; cj = 0; }
  const float* X = (const float*)(p.ws + OFF_X);
  float* Xw = (float*)(p.ws + (dry ? OFF_X2 : OFF_X));
  const bf16_t* Qb = (const bf16_t*)(p.ws + OFF_Q);
  const bf16_t* KB = (const bf16_t*)(p.ws + OFF_KEYB) + (size_t)l * 2 * 128 * 64;
  const bf16_t* H = (const bf16_t*)(p.ws + OFF_H);
  bf16_t* Hw = (bf16_t*)(p.ws + (dry ? OFF_H2 : OFF_H));
  float* Yw = dry ? (float*)(p.ws + OFF_X2) : p.out + OUT_Y;
  const float* mod = (const float*)(p.ws + OFF_MOD);
  const unsigned char* U8 = (const unsigned char*)(p.ws + OFF_UB) + (size_t)l * NEXP * 2048;
  const unsigned char* V8 = U8 + 1024;
  const float* USC = (const float*)(p.ws + OFF_USC) + (size_t)l * NEXP;
  const float* VSC = (const float*)(p.ws + OFF_VSC) + (size_t)l * NEXP;
  const int gw = gr.lq * 4 + wave, nw = gr.QB * 4;
  const int q0 = gr.j * QTOK;
#pragma unroll 1
  for (int tb = gw; tb < QTOK; tb += 3 * nw) {
    {
      const int c16 = lane & 15, quad = lane >> 4;
#pragma unroll 1
      for (int jc = 0; jc < 4; ++jc) {
        const int j = jc >> 1, c = (jc & 1) * 16 + c16;
        int ti = c >> 3; if (ti > 2) ti = 2;
        const int hh = c & 7;
        int tok = tb + ti * nw; if (tok >= QTOK) tok = tb;
        tok = tok_g(gr.g, q0 + tok);
        const bf16_t* qp = Qb + (size_t)tok * DM + hh * 128 + j * 64 + quad * 8;
        const bf16x8 b0 = *(const bf16x8*)qp, b1 = *(const bf16x8*)(qp + 32);
        const bf16_t* kp = KB + (size_t)(j * 128 + c16) * 64 + quad * 8;
        float top[16];
#pragma unroll
        for (int s = 0; s < 16; ++s) top[s] = -3.0e38f;
#pragma unroll
        for (int nb = 0; nb < 8; ++nb) {
          const bf16x8 a0 = *(const bf16x8*)(kp + nb * 16 * 64), a1 = *(const bf16x8*)(kp + nb * 16 * 64 + 32);
          f32x4 acc = {0.f, 0.f, 0.f, 0.f};
          acc = __builtin_amdgcn_mfma_f32_16x16x32_bf16(a0, b0, acc, 0, 0, 0);
          acc = __builtin_amdgcn_mfma_f32_16x16x32_bf16(a1, b1, acc, 0, 0, 0);
#pragma unroll
          for (int e = 0; e < 4; ++e) {
            float v = __uint_as_float((__float_as_uint(acc[e]) & ~0x7Fu) | (unsigned)(nb * 16 + quad * 4 + e));
#pragma unroll
            for (int s = 0; s < 16; ++s) {
              float hi_ = fmaxf(top[s], v);
              v = fminf(top[s], v);
              top[s] = hi_;
            }
          }
        }
#pragma unroll
        for (int step = 16; step <= 32; step <<= 1) {
          float oth[16];
#pragma unroll
          for (int s = 0; s < 16; ++s) oth[s] = __shfl_xor(top[s], step);
#pragma unroll
          for (int s = 0; s < 16; ++s) top[s] = fmaxf(top[s], oth[15 - s]);
#pragma unroll
          for (int dist = 8; dist >= 1; dist >>= 1) {
#pragma unroll
            for (int s = 0; s < 16; ++s) {
              if ((s & dist) == 0) {
                float a = top[s], b = top[s + dist];
                top[s] = fmaxf(a, b);
                top[s + dist] = fminf(a, b);
              }
            }
          }
        }
        if (quad == 0 && c < 24) {
          unsigned* dstp = scr3 + ((c >> 3) * 16 + 2 * hh + j) * 16;
#pragma unroll
          for (int s4 = 0; s4 < 4; ++s4)
            *(uint4*)(dstp + s4 * 4) = make_uint4(__float_as_uint(top[s4 * 4 + 0]), __float_as_uint(top[s4 * 4 + 1]),
                                                  __float_as_uint(top[s4 * 4 + 2]), __float_as_uint(top[s4 * 4 + 3]));
        }
      }
    }
    __builtin_amdgcn_fence(__ATOMIC_RELEASE, "wavefront");
    __builtin_amdgcn_wave_barrier();
    __builtin_amdgcn_fence(__ATOMIC_ACQUIRE, "wavefront");
#pragma unroll 1
    for (int ti3 = 0; ti3 < 3; ++ti3) {
    if (tb + ti3 * nw >= QTOK) break;
    const int t = tok_g(gr.g, q0 + tb + ti3 * nw);
    unsigned* scr = scr3 + ti3 * 256;
    for (int hd = 0; hd < 8; ++hd) {
      unsigned ka = scr[(2 * hd) * 16 + ci], kb = scr[(2 * hd + 1) * 16 + cj];
      float cand = cvalid ? (__uint_as_float(ka & ~0x7Fu) + __uint_as_float(kb & ~0x7Fu)) : -3.0e38f;
      int rank = 0;
#pragma unroll
      for (int m = 0; m < 50; ++m) {
        float sv = __uint_as_float(__builtin_amdgcn_readlane(__float_as_uint(cand), m));
        rank += (sv > cand) ? 1 : 0;
      }
      bool sel = cvalid && rank < 16;
      unsigned long long bm = __ballot(sel);
      int slot = __builtin_amdgcn_mbcnt_hi((unsigned)(bm >> 32), __builtin_amdgcn_mbcnt_lo((unsigned)bm, 0));
      unsigned long long b0 = __ballot(cvalid && rank == 0);
      int l0 = __ffsll((long long)b0) - 1;
      float mx = __uint_as_float(__builtin_amdgcn_readlane(__float_as_uint(cand), l0));
      float e = sel ? __expf(cand - mx) : 0.f;
      float sum = wave_sum(e);
      if (sel && slot < 16) {
        eidx[hd * 16 + slot] = (ka & 0x7Fu) * 128u + (kb & 0x7Fu);
        egate[hd * 16 + slot] = e / sum;
      }
    }
    __builtin_amdgcn_fence(__ATOMIC_RELEASE, "wavefront");
    __builtin_amdgcn_wave_barrier();
    __builtin_amdgcn_fence(__ATOMIC_ACQUIRE, "wavefront");
    const float* modv = mod + (size_t)(l * 3 + tok_grp(t)) * 6144;
    f2v_t h2[8], outp[8];
    {
#pragma unroll
      for (int j = 0; j < 4; ++j) {
        const uint2 hu = *(const uint2*)(H + (size_t)t * DM + j * 256 + lane * 4);
        h2[2 * j] = f2v_t{bflo(hu.x), bfhi(hu.x)};
        h2[2 * j + 1] = f2v_t{bflo(hu.y), bfhi(hu.y)};
      }
#pragma unroll
      for (int w = 0; w < 8; ++w) outp[w] = f2v_t{0.f, 0.f};
    }
    {
      float* eus = (float*)scr;
#pragma unroll
      for (int j = 0; j < 2; ++j) {
        const int i = lane + 64 * j;
        const unsigned id = eidx[i];
        eus[i] = USC[id];
        eus[128 + i] = egate[i] * VSC[id];
      }
    }
    __builtin_amdgcn_fence(__ATOMIC_RELEASE, "wavefront");
    __builtin_amdgcn_wave_barrier();
    __builtin_amdgcn_fence(__ATOMIC_ACQUIRE, "wavefront");
    const float* eus = (const float*)scr;
    u32x4 ub[16], vb[16];
#pragma unroll 1
    for (int hd = 0; hd < 8; ++hd) {
#pragma unroll
      for (int k = 0; k < 16; ++k) {
        unsigned id = __builtin_amdgcn_readfirstlane(eidx[hd * 16 + k]);
        ub[k] = *(const u32x4*)(U8 + ((size_t)id << 11) + lane * 16);
      }
#pragma unroll
      for (int k = 0; k < 16; ++k) {
        unsigned id = __builtin_amdgcn_readfirstlane(eidx[hd * 16 + k]);
        vb[k] = *(const u32x4*)(V8 + ((size_t)id << 11) + lane * 16);
      }
      float pd[16];
#pragma unroll
      for (int k = 0; k < 16; ++k) {
        f2v_t acc = {0.f, 0.f};
#pragma unroll
        for (int w = 0; w < 4; ++w) {
          acc = __builtin_elementwise_fma(__builtin_amdgcn_cvt_pk_f32_fp8((int)ub[k][w], false), h2[2 * w], acc);
          acc = __builtin_elementwise_fma(__builtin_amdgcn_cvt_pk_f32_fp8((int)ub[k][w], true), h2[2 * w + 1], acc);
        }
        pd[k] = acc.x + acc.y;
      }
      const bool b0 = lane & 1, b1 = lane & 2, b2 = lane & 4, b3 = lane & 8;
      float w8[8], w4[4], w2[2], z;
#pragma unroll
      for (int i = 0; i < 8; ++i) { float snd = b0 ? pd[i] : pd[8 + i], kp = b0 ? pd[8 + i] : pd[i]; w8[i] = kp + __shfl_xor(snd, 1); }
#pragma unroll
      for (int i = 0; i < 4; ++i) { float snd = b1 ? w8[i] : w8[4 + i], kp = b1 ? w8[4 + i] : w8[i]; w4[i] = kp + __shfl_xor(snd, 2); }
#pragma unroll
      for (int i = 0; i < 2; ++i) { float snd = b2 ? w4[i] : w4[2 + i], kp = b2 ? w4[2 + i] : w4[i]; w2[i] = kp + __shfl_xor(snd, 4); }
      { float snd = b3 ? w2[0] : w2[1], kp = b3 ? w2[1] : w2[0]; z = kp + __shfl_xor(snd, 8); }
      z += __shfl_xor(z, 16); z += __shfl_xor(z, 32);
      const int kmine = ((lane & 1) << 3) | ((lane & 2) << 1) | ((lane & 4) >> 1) | ((lane & 8) >> 3);
      const float cfl = eus[128 + hd * 16 + kmine] * gelu_t(z * eus[hd * 16 + kmine]);
#pragma unroll
      for (int k = 0; k < 16; ++k) {
        const int src = ((k >> 3) & 1) | (((k >> 2) & 1) << 1) | (((k >> 1) & 1) << 2) | ((k & 1) << 3);
        const float cf = __uint_as_float(__builtin_amdgcn_readlane(__float_as_uint(cfl), src));
        const f2v_t c2 = {cf, cf};
#pragma unroll
        for (int w = 0; w < 4; ++w) {
          outp[2 * w] = __builtin_elementwise_fma(__builtin_amdgcn_cvt_pk_f32_fp8((int)vb[k][w], false), c2, outp[2 * w]);
          outp[2 * w + 1] = __builtin_elementwise_fma(__builtin_amdgcn_cvt_pk_f32_fp8((int)vb[k][w], true), c2, outp[2 * w + 1]);
        }
      }
    }
    float x1[16], outv[16];
#pragma unroll
    for (int w = 0; w < 8; ++w) { outv[2 * w] = outp[w].x; outv[2 * w + 1] = outp[w].y; }
    load_row16(X + (size_t)t * DM, lane, x1);
    {
      float g2[16], g[16], bb[16];
      load_row16(modv + 5120, lane, g2);
      load_row16(p.ln_g + (size_t)(l * 2 + 1) * DM, lane, g);
      load_row16(p.ln_b + (size_t)(l * 2 + 1) * DM, lane, bb);
#pragma unroll
      for (int i = 0; i < 16; ++i) x1[i] = ALPHA * x1[i] + g2[i] * outv[i];
      float mu, rstd;
      ln_stats(x1, mu, rstd);
#pragma unroll
      for (int i = 0; i < 16; ++i) x1[i] = (x1[i] - mu) * rstd * g[i] + bb[i];
      if (l == DEPTH - 1) {
        store_row16(Yw + (size_t)t * DM, lane, x1);
      } else {
        store_row16(Xw + (size_t)t * DM, lane, x1);
        const float* modn = mod + (size_t)((l + 1) * 3 + tok_grp(t)) * 6144;
        ln_stats(x1, mu, rstd);
        float sh[16], scv[16];
        load_row16(modn, lane, sh);
        load_row16(modn + 1024, lane, scv);
#pragma unroll
        for (int i = 0; i < 16; ++i) x1[i] = (x1[i] - mu) * rstd * (1.f + scv[i]) + sh[i];
#pragma unroll
        for (int j = 0; j < 4; ++j) {
          uint2 hu; hu.x = pk2(x1[4 * j], x1[4 * j + 1]); hu.y = pk2(x1[4 * j + 2], x1[4 * j + 3]);
          *(uint2*)(Hw + (size_t)t * DM + j * 256 + lane * 4) = hu;
        }
      }
    }
    }
  }
}

struct EpiG1 {
  const Params* p; int l;
  DI void operator()(int rb, int cb, const f32x16& acc, int r, int h) const {
    bf16_t* P = (bf16_t*)(p->ws + OFF_P);
    const int col = cb + r;
    const bool lat = rb >= TCTX;
    float v[16];
#pragma unroll
    for (int e = 0; e < 16; ++e) v[e] = acc[e];
    if (cb < 512) {
#pragma unroll
      for (int e = 0; e < 16; ++e) v[e] = gelu_t(v[e]);
    } else if (lat) {
      const bool ropeB = (cb < 896);
      const bool ropeC = (cb >= 1024 && cb < 1536);
      if (ropeB || ropeC) {
        const int dim = ropeB ? 64 : 32, q = ropeB ? 16 : 8;
        const float* tab = (const float*)(p->ws + (ropeB ? OFF_ROPEB : OFF_ROPEC));
        const int di = col & (dim - 1);
        const bool up = (di & q) != 0;
#pragma unroll
        for (int e = 0; e < 16; ++e) {
          int pos = (rb + crow(e, h) - TCTX) & 1023;
          float partner = __shfl_xor(v[e], q);
          float cs = tab[pos * dim + di], sn = tab[1024 * dim + pos * dim + di];
          v[e] = v[e] * cs + (up ? partner : -partner) * sn;
        }
      }
    }
#pragma unroll
    for (int e = 0; e < 16; ++e) P[(size_t)(rb + crow(e, h)) * PC + col] = f2bf(v[e]);
    if (!lat) {
      float* dst = nullptr; int width = 0, c0 = 0;
      if (cb >= 768 && cb < 896) { dst = p->out + OUT_WK; width = 128; c0 = 768; }
      else if (cb >= 896 && cb < 1024) { dst = p->out + OUT_WV; width = 128; c0 = 896; }
      else if (cb >= 1280 && cb < 1536) { dst = p->out + OUT_DK; width = 256; c0 = 1280; }
      else if (cb >= 1536 && cb < 1792) { dst = p->out + OUT_DV; width = 256; c0 = 1536; }
      if (dst) {
#pragma unroll
        for (int e = 0; e < 16; ++e) {
          int t = rb + crow(e, h), b = t >> 8, s = t & 255;
          __builtin_nontemporal_store(v[e], &dst[((size_t)(b * DEPTH + l) * 256 + s) * width + (col - c0)]);
        }
      }
    }
  }
};
struct EpiG2 {
  const Params* p; int l; bool dry;
  DI void operator()(int rb, int cb, const f32x16& acc, int r, int h) const {
    const float* X = (const float*)(p->ws + OFF_X);
    float* Xo = (float*)(p->ws + (dry ? OFF_X2 : OFF_X));
    const int col = cb + r;
    const float g1 = ((const float*)(p->ws + OFF_MOD))[(size_t)(l * 3 + tok_grp(rb)) * 6144 + 2048 + col];
#pragma unroll
    for (int e = 0; e < 16; ++e) {
      size_t idx = (size_t)(rb + crow(e, h)) * DM + col;
      Xo[idx] = ALPHA * X[idx] + g1 * acc[e];
    }
  }
};
struct EpiG3 {
  const Params* p;
  DI void operator()(int rb, int cb, const f32x16& acc, int r, int h) const {
    bf16_t* Q = (bf16_t*)(p->ws + OFF_Q);
    const int col = cb + r;
#pragma unroll
    for (int e = 0; e < 16; ++e) Q[(size_t)(rb + crow(e, h)) * DM + col] = f2bf(acc[e]);
  }
};

#define XB_TMO      128
#define XB_XCNT(j)  (256  + 64 * (j))
#define XB_XSUB(j)  (1280 + 64 * (j))
#define XB_XGEN(j)  (2304 + 64 * (j))
#define XB_TOP      3328
#define XB_TOPGEN   3392
#define XCD_BAR_WORDS 3456
#define XB_SPIN_CAP (1u << 18)
#define LAS __attribute__((address_space(3)))
DI unsigned xb_ld(unsigned* p) { return __hip_atomic_load(p, __ATOMIC_RELAXED, __HIP_MEMORY_SCOPE_AGENT); }
DI unsigned xb_add(unsigned* p, unsigned v) { return __hip_atomic_fetch_add(p, v, __ATOMIC_RELAXED, __HIP_MEMORY_SCOPE_AGENT); }
DI unsigned xb_xcc_id() { return (unsigned)__builtin_amdgcn_s_getreg((3 << 11) | 20) & 0xFu; }
#define XB_SPIN(cond, bar) do { unsigned _sp = 0; while (cond) { __builtin_amdgcn_s_sleep(1); \
    if ((++_sp & 255u) == 0u) { if (xb_ld(&(bar)[XB_TMO])) break; if (_sp > XB_SPIN_CAP) { atomicAdd(&(bar)[XB_TMO], 1u); break; } } } } while (0)
struct XcdBarrier { unsigned* bar; unsigned x; volatile LAS unsigned* st; };
DI XcdBarrier xcd_barrier_post(unsigned* bar, volatile LAS unsigned* st) {
  XcdBarrier b; b.bar = bar; b.x = xb_xcc_id(); b.st = st;
  if (threadIdx.x == 0) (void)xb_add(&bar[XB_XCNT(b.x)], 1u);
  return b;
}
DI void xcd_barrier_complete(unsigned* bar, unsigned x, unsigned& nloc, unsigned& nx, unsigned G) {
  unsigned sum, cnt, mine, sp = 0u;
  for (;;) {
    sum = 0u; cnt = 0u; mine = 0u;
#pragma unroll
    for (unsigned j = 0; j < 16; ++j) { const unsigned c = xb_ld(&bar[XB_XCNT(j)]); sum += c; cnt += (c > 0u) ? 1u : 0u; mine = (j == x) ? c : mine; }
    if (sum == G) break;
    __builtin_amdgcn_s_sleep(1);
    if ((++sp & 255u) == 0u) { if (xb_ld(&bar[XB_TMO])) break; if (sp > XB_SPIN_CAP) { atomicAdd(&bar[XB_TMO], 1u); break; } }
  }
  nloc = mine > 0u ? mine : 1u; nx = cnt > 0u ? cnt : 1u;
}
DI void xcd_barrier(unsigned* bar_, volatile LAS unsigned* st_, unsigned G) {
  XcdBarrier b; b.bar = bar_; b.x = xb_xcc_id(); b.st = st_;
  asm volatile("s_waitcnt vmcnt(0)" ::: "memory");
  __syncthreads();
  if (threadIdx.x == 0) {
    unsigned* bar = b.bar;
    __builtin_amdgcn_s_waitcnt(0);
    unsigned nloc = b.st[0], nx = b.st[1];
    if (nloc == 0u) { xcd_barrier_complete(bar, b.x, nloc, nx, G); b.st[0] = nloc; b.st[1] = nx; }
    const unsigned old = xb_add(&bar[XB_XSUB(b.x)], 1u);
    const unsigned gen = old / nloc;
    if (old + 1u == (gen + 1u) * nloc) {
      __builtin_amdgcn_fence(__ATOMIC_RELEASE, "agent");
      asm volatile("s_waitcnt vmcnt(0)" ::: "memory");
      const unsigned og = xb_add(&bar[XB_TOP], 1u);
      const unsigned tg = og / nx;
      if (og + 1u == (tg + 1u) * nx) xb_add(&bar[XB_TOPGEN], 1u);
      else XB_SPIN(xb_ld(&bar[XB_TOPGEN]) == tg, bar);
      __builtin_amdgcn_fence(__ATOMIC_ACQUIRE, "agent");
      xb_add(&bar[XB_XGEN(b.x)], 1u);
      asm volatile("s_waitcnt vmcnt(0)" ::: "memory");
    } else {
      XB_SPIN(xb_ld(&bar[XB_XGEN(b.x)]) == gen, bar);
      __builtin_amdgcn_fence(__ATOMIC_ACQUIRE, "agent");
      asm volatile("s_waitcnt vmcnt(0)" ::: "memory");
    }
  }
  __syncthreads();
}

constexpr int SMEM_BYTES = 78848;
static_assert(SMEM_BYTES >= 4 * 1024 * 4, "peer smem");
static_assert(SMEM_BYTES >= 2 * 2 * 128 * GSTR * 2, "gemm smem");
static_assert(SMEM_BYTES >= (128 * KSTR + 64 * VSTR) * 2, "attn smem");

__global__ void __launch_bounds__(NTHR, 2) fwd_megakernel(Params p) {
  __shared__ __attribute__((aligned(16))) char smem[SMEM_BYTES];
  __shared__ uint4 xb_words, xg_words;
  cg::grid_group grid = cg::this_grid();
  if (threadIdx.x == 0) { xb_words = make_uint4(0u, 0u, 0u, 0u); xg_words = make_uint4(0u, 0u, 0u, 0u); }
  __syncthreads();
  const Grp gr = my_grp();
  unsigned* gbar = (unsigned*)(p.ws + OFF_BAR);
  unsigned* mbar = (unsigned*)(p.ws + OFF_BAR + (size_t)(1 + gr.g) * 16384);
  unsigned* flag = (unsigned*)(p.ws + OFF_BAR + 3 * 16384);
  (void)xcd_barrier_post(gbar, (volatile LAS unsigned*)&xb_words);
  (void)xcd_barrier_post(mbar, (volatile LAS unsigned*)&xg_words);
  if (p.ws == nullptr) grid.sync();
#define GBARRIER() xcd_barrier(gbar, (volatile LAS unsigned*)&xb_words, gridDim.x)
#define MBARRIER() xcd_barrier(mbar, (volatile LAS unsigned*)&xg_words, (unsigned)gr.GB)
  phase0(p, smem);
  GBARRIER();
  const int nshard = 8;
  phase_modreduce(p);
  GBARRIER();
  phase_ln0(p);
  GBARRIER();
  if (SPLIT_OFFSET && gr.g == 1) {
    convert_tables(p, 2 * NEXP, 4 * NEXP, gr.lb * 4 + (int)(threadIdx.x >> 6), gr.GB * 4);
    __threadfence();
    __syncthreads();
    if (threadIdx.x == 0) atomicAdd(flag, 1u);
  }
  int* ctr = (int*)(p.ws + OFF_QCTR) + gr.g * (32 * 512);
  for (int l = 0; l < DEPTH; ++l) {
    gemm_phase(gr, nshard, (const bf16_t*)(p.ws + OFF_H), (const bf16_t*)(p.ws + OFF_WINT) + (size_t)l * PC * DM, PC, smem, ctr + ((l * 4 + 0) * 2) * 512, EpiG1{&p, l});
    MBARRIER();
    phase_mixers(gr, nshard, p, l, smem, ctr + ((l * 4 + 1) * 2) * 512);
    MBARRIER();
    gemm_phase(gr, nshard, (const bf16_t*)(p.ws + OFF_O), (const bf16_t*)(p.ws + OFF_WOUTT) + (size_t)l * DM * DM, DM, smem, ctr + ((l * 4 + 2) * 2) * 512, EpiG2{&p, l, false});
    MBARRIER();
    phase_ln1(gr, p, l, false);
    MBARRIER();
    gemm_phase(gr, nshard, (const bf16_t*)(p.ws + OFF_H), (const bf16_t*)(p.ws + OFF_WQT) + (size_t)l * DM * DM, DM, smem, ctr + ((l * 4 + 3) * 2) * 512, EpiG3{&p});
    if (SPLIT_OFFSET && l == 2 && gr.g == 0) {
      if (threadIdx.x == 0) { XB_SPIN(xb_ld(flag) < (unsigned)gr.GB, gbar); }
      __syncthreads();
    }
    MBARRIER();
    phase_peer(gr, p, l, smem, false);
    if (l + 1 < DEPTH) MBARRIER();
  }
}

extern "C" void kernel_launch(void* const* d_in, const int* in_sizes, int n_in, void* d_out, int out_size, void* d_ws,
                              size_t ws_size, hipStream_t stream) {
  static int grid_blocks = 0;
  if (!grid_blocks) {
    int dev = 0, cus = 0, per_cu = 0;
    (void)hipGetDevice(&dev);
    (void)hipDeviceGetAttribute(&cus, hipDeviceAttributeMultiprocessorCount, dev);
    (void)hipOccupancyMaxActiveBlocksPerMultiprocessor(&per_cu, fwd_megakernel, NTHR, 0);
    if (per_cu > 2) per_cu = 2;
    if (per_cu < 1) per_cu = 1;
    grid_blocks = cus * per_cu;
  }
  Params p{};
  const float** pp = (const float**)&p;
  for (int i = 0; i < 26; ++i) pp[i] = (const float*)d_in[i];
  p.out = (float*)d_out;
  p.ws = (char*)d_ws;
  void* args[] = {&p};
  (void)hipMemsetAsync((char*)d_ws + OFF_BAR, 0, 4 * 16384, stream);
  hipError_t e = hipLaunchCooperativeKernel((void*)fwd_megakernel, dim3(grid_blocks), dim3(NTHR), args, 0, stream);
  if (e != hipSuccess) fprintf(stderr, "cooperative launch failed: %s (grid %d)\n", hipGetErrorString(e), grid_blocks);
}
```

```cpp
#include <hip/hip_runtime.h>
#include <hip/hip_cooperative_groups.h>
#include <cstdio>
namespace cg = cooperative_groups;

#define DI __device__ __forceinline__
typedef short bf16x8 __attribute__((ext_vector_type(8)));
typedef short s16x4 __attribute__((ext_vector_type(4)));
typedef float f32x16 __attribute__((ext_vector_type(16)));
typedef unsigned short bf16_t;
typedef unsigned u32x4 __attribute__((ext_vector_type(4)));
#define MFMA(a, b, c) __builtin_amdgcn_mfma_f32_32x32x16_bf16((a), (b), (c), 0, 0, 0)

constexpr int DM = 1024, TCTX = 4096, TLAT = 2048, NT = 6144, PC = 2048, DEPTH = 4;
constexpr int NEXP = 16384;
constexpr float ALPHA = 1.681792830507429f;
constexpr float LN_EPS = 1e-5f;
constexpr int NTHR = 256;

constexpr size_t OUT_Y = 0;
constexpr size_t OUT_WK = 6291456, OUT_WV = 8388608, OUT_DK = 10485760, OUT_DV = 14680064;

constexpr size_t SZ_WINT = (size_t)DEPTH * PC * DM * 2;
constexpr size_t SZ_WSQ = (size_t)DEPTH * DM * DM * 2;
constexpr size_t SZ_TAB = (size_t)DEPTH * NEXP * DM * 2;
constexpr size_t OFF_WINT = 0;
constexpr size_t OFF_WOUTT = OFF_WINT + SZ_WINT;
constexpr size_t OFF_WQT = OFF_WOUTT + SZ_WSQ;
constexpr size_t OFF_UB = OFF_WQT + SZ_WSQ;
constexpr size_t OFF_VB = OFF_UB + SZ_TAB;
constexpr size_t OFF_X = OFF_VB + SZ_TAB;
constexpr size_t OFF_H = OFF_X + (size_t)NT * DM * 4;
constexpr size_t OFF_P = OFF_H + (size_t)NT * DM * 2;
constexpr size_t OFF_O = OFF_P + (size_t)NT * PC * 2;
constexpr size_t OFF_Q = OFF_O + (size_t)NT * DM * 2;
constexpr size_t OFF_MOD = OFF_Q + (size_t)NT * DM * 4;
constexpr size_t OFF_MODP = OFF_MOD + (size_t)DEPTH * 3 * 6144 * 4;
constexpr size_t OFF_ROPEB = OFF_MODP + (size_t)DEPTH * 16 * 3 * 6144 * 4;
constexpr size_t OFF_ROPEC = OFF_ROPEB + (size_t)1024 * 64 * 2 * 4;
constexpr size_t OFF_LAM = OFF_ROPEC + (size_t)1024 * 32 * 2 * 4;
constexpr size_t OFF_CTR = OFF_LAM + 256;
constexpr size_t OFF_CWKB = OFF_CTR + 1024;
constexpr size_t OFF_CWVB = OFF_CWKB + (size_t)2 * 4 * 256 * 128 * 2;
constexpr size_t OFF_CDKB = OFF_CWVB + (size_t)2 * 4 * 256 * 128 * 2;
constexpr size_t OFF_CDVB = OFF_CDKB + (size_t)2 * 4 * 256 * 256 * 2;
constexpr size_t OFF_USC = OFF_CDVB + (size_t)2 * 4 * 256 * 256 * 2;
constexpr size_t OFF_VSC = OFF_USC + (size_t)DEPTH * NEXP * 4;
constexpr size_t OFF_KEYB = OFF_VSC + (size_t)DEPTH * NEXP * 4;
constexpr size_t OFF_BAR = OFF_KEYB + (size_t)DEPTH * 2 * 128 * 64 * 2; constexpr size_t OFF_BAR_UNUSED = OFF_CDVB + (size_t)2 * 4 * 256 * 256 * 2;
constexpr size_t OFF_X2 = OFF_BAR + 4 * 16384;
constexpr size_t OFF_H2 = OFF_X2 + (size_t)NT * DM * 4;
constexpr size_t OFF_QCTR = OFF_H2 + (size_t)NT * DM * 2;
constexpr int REP_P0 = 1, REP_G1 = 1, REP_MIX = 1, REP_G2 = 1, REP_LN1 = 1, REP_G3 = 1, REP_PEER = 1;
constexpr int SLOT_OFF = 78000;

struct Params {
  const float *x_prompt, *x_sample, *c, *cwk, *cwv, *cdk, *cdv, *c_ctx, *w_mod, *b_mod, *w_in, *w_out, *chunk_w, *chunk_b,
      *win_sink, *lam_q, *lam_k, *subln_g, *pool_w, *pool_scale, *ln_g, *ln_b, *peer_wq, *peer_keys, *peer_u, *peer_v;
  float* out;
  char* ws;
};

typedef __bf16 bf2v_t __attribute__((ext_vector_type(2)));
typedef float f2v_t __attribute__((ext_vector_type(2)));
DI unsigned pk2(float a, float b) { f2v_t v = {a, b}; return __builtin_bit_cast(unsigned, __builtin_convertvector(v, bf2v_t)); }
DI unsigned short f2bf(float x) { return (unsigned short)(pk2(x, 0.f) & 0xffffu); }
DI float bflo(unsigned u) { return __uint_as_float(u << 16); }
DI float bfhi(unsigned u) { return __uint_as_float(u & 0xffff0000u); }
DI float gelu_t(float x) { return x / (1.f + __expf(-1.5957691216057308f * (x + 0.044715f * x * x * x))); }
DI float wave_sum(float v) {
#pragma unroll
  for (int o = 32; o; o >>= 1) v += __shfl_xor(v, o);
  return v;
}
typedef __bf16 bf2_t __attribute__((ext_vector_type(2)));
DI float dot2bf(unsigned a, unsigned b, float c) { return __builtin_amdgcn_fdot2_f32_bf16(__builtin_bit_cast(bf2_t, a), __builtin_bit_cast(bf2_t, b), c, false); }
typedef float f32x4nt_t __attribute__((ext_vector_type(4)));
DI float4 ld_nt4(const float* p) { const f32x4nt_t t = __builtin_nontemporal_load((const f32x4nt_t*)p); return make_float4(t[0], t[1], t[2], t[3]); }
DI int opaque_tid() { int t = threadIdx.x; asm volatile("" : "+v"(t)); return t; }
struct Grp { int g, lb, GB, j, lq, QB; };
DI Grp my_grp() { Grp r; r.GB = (int)gridDim.x >> 1; r.g = (int)blockIdx.x & 1; r.lb = (int)blockIdx.x >> 1; r.j = r.lb & 3; r.lq = r.lb >> 2; r.QB = r.GB >> 2; return r; }
DI int mtile_g(int g, int mt) { return mt < 16 ? g * 16 + mt : 32 + g * 8 + (mt - 16); }
DI int tok_g(int g, int u) { return u < 2048 ? g * 2048 + u : TCTX + g * 1024 + (u - 2048); }
constexpr int GTOK = 3072;
constexpr int QTOK = 768;
constexpr bool SPLIT_OFFSET = true;
DI int next_tile_q(const Grp& gr, int* ctrq, char* smem, bool& first) {
  int* slot = (int*)(smem + SLOT_OFF);
  if (first) { first = false; return gr.lq; }
  __syncthreads();
  if (threadIdx.x == 0) *slot = gr.QB + atomicAdd(ctrq, 1);
  __syncthreads();
  return *slot;
}
DI int next_item(const Grp& gr, int* ctr, char* smem, bool& first, int nshard) {
  int* slot = (int*)(smem + SLOT_OFF);
  if (first) { first = false; return gr.lb; }
  __syncthreads();
  if (threadIdx.x == 0) {
    const int q = (nshard == 8) ? (gr.lb & 7) : 0;
    *slot = gr.GB + q + nshard * atomicAdd(ctr + q * 64, 1);
  }
  __syncthreads();
  return *slot;
}
DI int crow(int reg, int h) { return (reg & 3) + 8 * (reg >> 2) + 4 * h; }
DI uint4 pack8(const float* v) {
  uint4 r;
  r.x = pk2(v[0], v[1]); r.y = pk2(v[2], v[3]); r.z = pk2(v[4], v[5]); r.w = pk2(v[6], v[7]);
  return r;
}
DI bf16x8 as_bf16x8(uint4 u) { return __builtin_bit_cast(bf16x8, u); }

DI void load_row(const float* p, int lane, float (&v)[16]) {
#pragma unroll
  for (int c = 0; c < 2; ++c) {
    float4 a = *(const float4*)(p + c * 512 + lane * 8);
    float4 b = *(const float4*)(p + c * 512 + lane * 8 + 4);
    v[c * 8 + 0] = a.x; v[c * 8 + 1] = a.y; v[c * 8 + 2] = a.z; v[c * 8 + 3] = a.w;
    v[c * 8 + 4] = b.x; v[c * 8 + 5] = b.y; v[c * 8 + 6] = b.z; v[c * 8 + 7] = b.w;
  }
}
DI void store_row(float* p, int lane, const float (&v)[16]) {
#pragma unroll
  for (int c = 0; c < 2; ++c) {
    *(float4*)(p + c * 512 + lane * 8) = make_float4(v[c * 8 + 0], v[c * 8 + 1], v[c * 8 + 2], v[c * 8 + 3]);
    *(float4*)(p + c * 512 + lane * 8 + 4) = make_float4(v[c * 8 + 4], v[c * 8 + 5], v[c * 8 + 6], v[c * 8 + 7]);
  }
}
DI void store_row_bf(bf16_t* p, int lane, const float (&v)[16]) {
#pragma unroll
  for (int c = 0; c < 2; ++c) *(uint4*)(p + c * 512 + lane * 8) = pack8(&v[c * 8]);
}
DI void load_row16(const float* p, int lane, float (&v)[16]) {
#pragma unroll
  for (int j = 0; j < 4; ++j) {
    float4 a = *(const float4*)(p + j * 256 + lane * 4);
    v[4 * j] = a.x; v[4 * j + 1] = a.y; v[4 * j + 2] = a.z; v[4 * j + 3] = a.w;
  }
}
DI void store_row16(float* p, int lane, const float (&v)[16]) {
#pragma unroll
  for (int j = 0; j < 4; ++j) *(float4*)(p + j * 256 + lane * 4) = make_float4(v[4 * j], v[4 * j + 1], v[4 * j + 2], v[4 * j + 3]);
}
DI void ln_stats(const float (&v)[16], float& mu, float& rstd) {
  float s = 0.f;
#pragma unroll
  for (int i = 0; i < 16; ++i) s += v[i];
  s = wave_sum(s);
  mu = s * (1.f / 1024.f);
  float q = 0.f;
#pragma unroll
  for (int i = 0; i < 16; ++i) { float d = v[i] - mu; q += d * d; }
  q = wave_sum(q);
  rstd = rsqrtf(q * (1.f / 1024.f) + LN_EPS);
}
DI int tok_grp(int t) { return t < TCTX ? 0 : 1 + ((t - TCTX) >> 10); }
DI void ln_mod_to_bf(const float (&v)[16], const float* modv, int shoff, bf16_t* dst, int lane) {
  float mu, rstd;
  ln_stats(v, mu, rstd);
  float sh[16], sc[16], h[16];
  load_row(modv + shoff, lane, sh);
  load_row(modv + shoff + 1024, lane, sc);
#pragma unroll
  for (int i = 0; i < 16; ++i) h[i] = (v[i] - mu) * rstd * (1.f + sc[i]) + sh[i];
  store_row_bf(dst, lane, h);
}

DI void convert_tables(const Params& p, int r0, int r1, int gw, int nw) {
  char* ws = p.ws;
  const int lane = opaque_tid() & 63;
  const int nrow = r1 - r0;
  for (int bi = gw * 4; bi < 2 * nrow; bi += nw * 4) {
    const int tb = bi >= nrow ? 1 : 0;
    const int row = r0 + (bi - tb * nrow);
    const float* src = (tb ? p.peer_v : p.peer_u) + ((size_t)row << 10) + lane * 4;
    unsigned char* dst = (unsigned char*)(ws + OFF_UB) + ((size_t)row << 11) + tb * 1024 + lane * 16;
    float* sc = (float*)(ws + (tb ? OFF_VSC : OFF_USC)) + row;
    float4 x[4][4];
#pragma unroll
    for (int rr = 0; rr < 4; ++rr)
#pragma unroll
      for (int j = 0; j < 4; ++j) x[rr][j] = ld_nt4(src + (size_t)rr * 1024 + j * 256);
#pragma unroll
    for (int rr = 0; rr < 4; ++rr) {
      float am = 0.f;
#pragma unroll
      for (int j = 0; j < 4; ++j) am = fmaxf(am, fmaxf(fmaxf(fabsf(x[rr][j].x), fabsf(x[rr][j].y)), fmaxf(fabsf(x[rr][j].z), fabsf(x[rr][j].w))));
#pragma unroll
      for (int o = 32; o; o >>= 1) am = fmaxf(am, __shfl_xor(am, o));
      const float scale = am > 0.f ? 256.f / am : 1.f;
      u32x4 q;
#pragma unroll
      for (int j = 0; j < 4; ++j) {
        int w = __builtin_amdgcn_cvt_pk_fp8_f32(x[rr][j].x * scale, x[rr][j].y * scale, 0, false);
        w = __builtin_amdgcn_cvt_pk_fp8_f32(x[rr][j].z * scale, x[rr][j].w * scale, w, true);
        q[j] = (unsigned)w;
      }
      *(u32x4*)(dst + (size_t)rr * 2048) = q;
      if (lane == 0) sc[rr] = am > 0.f ? am * (1.f / 256.f) : 1.f;
    }
  }
}

DI void transpose_tile(const float* src, bf16_t* dst, int K, int N, int k0, int n0, float* tile  ) {
  const int tid = threadIdx.x;
#pragma unroll
  for (int i = 0; i < 4; ++i) {
    const int row = i * 16 + (tid >> 4), c4 = (tid & 15) * 4;
    const float4 v = ld_nt4(src + (size_t)(k0 + row) * N + n0 + c4);
    tile[row * 65 + c4] = v.x; tile[row * 65 + c4 + 1] = v.y; tile[row * 65 + c4 + 2] = v.z; tile[row * 65 + c4 + 3] = v.w;
  }
  __syncthreads();
#pragma unroll
  for (int i = 0; i < 2; ++i) {
    const int nrow = i * 32 + (tid >> 3), kc = (tid & 7) * 8;
    float f[8];
#pragma unroll
    for (int k = 0; k < 8; ++k) f[k] = tile[(kc + k) * 65 + nrow];
    *(uint4*)(dst + (size_t)(n0 + nrow) * K + k0 + kc) = pack8(f);
  }
  __syncthreads();
}

DI void phase0(const Params& p, char* smem) {
  const int tid = threadIdx.x;
  const int gthreads = gridDim.x * NTHR;
  const int gtid = blockIdx.x * NTHR + tid;
  char* ws = p.ws;
  for (int it = blockIdx.x; it < DEPTH * 1024; it += gridDim.x) {
    int l = it >> 10, r = it & 1023;
    if (r < 512) {
      int kt = r >> 5, nt = r & 31;
      transpose_tile(p.w_in + (size_t)l * DM * PC, (bf16_t*)(ws + OFF_WINT) + (size_t)l * PC * DM, DM, PC, kt * 64, nt * 64, (float*)smem);
    } else if (r < 768) {
      int q = r - 512, kt = q >> 4, nt = q & 15;
      transpose_tile(p.w_out + (size_t)l * DM * DM, (bf16_t*)(ws + OFF_WOUTT) + (size_t)l * DM * DM, DM, DM, kt * 64, nt * 64, (float*)smem);
    } else {
      int q = r - 768, kt = q >> 4, nt = q & 15;
      transpose_tile(p.peer_wq + (size_t)l * DM * DM, (bf16_t*)(ws + OFF_WQT) + (size_t)l * DM * DM, DM, DM, kt * 64, nt * 64, (float*)smem);
    }
  }
  {
    float* sv = (float*)smem;
    float* red = sv + 3 * 1024;
    for (int i = tid; i < 3 * 1024; i += NTHR) {
      int v = i >> 10, k = i & 1023;
      float x = (v == 0) ? p.c_ctx[k] : p.c[(v - 1) * 1024 + k];
      sv[i] = x / (1.f + __expf(-x));
    }
    __syncthreads();
    const int wave = tid >> 6, lane = tid & 63;
    float* modp = (float*)(ws + OFF_MODP);
    for (int it = blockIdx.x; it < DEPTH * 24 * 16; it += gridDim.x) {
      int l = it / 384, r = it % 384, nb = r >> 4, ks = r & 15;
      int kbase = ks * 64 + wave * 16;
      const float* wp = p.w_mod + ((size_t)l * DM + kbase) * 6144 + nb * 256 + lane * 4;
      float4 w[16];
#pragma unroll
      for (int k = 0; k < 16; ++k) w[k] = ld_nt4(wp + (size_t)k * 6144);
      float a[3][4];
#pragma unroll
      for (int v = 0; v < 3; ++v) { a[v][0] = a[v][1] = a[v][2] = a[v][3] = 0.f; }
#pragma unroll
      for (int k = 0; k < 16; ++k) {
#pragma unroll
        for (int v = 0; v < 3; ++v) {
          float s = sv[v * 1024 + kbase + k];
          a[v][0] += s * w[k].x; a[v][1] += s * w[k].y; a[v][2] += s * w[k].z; a[v][3] += s * w[k].w;
        }
      }
#pragma unroll
      for (int v = 0; v < 3; ++v)
        *(float4*)&red[(wave * 3 + v) * 256 + lane * 4] = make_float4(a[v][0], a[v][1], a[v][2], a[v][3]);
      __syncthreads();
      for (int i = tid; i < 768; i += NTHR) {
        int v = i >> 8, cidx = i & 255;
        float s = red[(0 * 3 + v) * 256 + cidx] + red[(1 * 3 + v) * 256 + cidx] + red[(2 * 3 + v) * 256 + cidx] + red[(3 * 3 + v) * 256 + cidx];
        modp[(((size_t)l * 16 + ks) * 3 + v) * 6144 + nb * 256 + cidx] = s;
      }
      __syncthreads();
    }
  }
  convert_tables(p, 0, (SPLIT_OFFSET ? 2 : 4) * NEXP, blockIdx.x * 4 + (tid >> 6), gridDim.x * 4);
  {
    const int n1 = 2 * 4 * 256 * 128 / 8, n2 = 2 * 4 * 256 * 256 / 8;
    for (int i = gtid; i < 2 * n1 + 2 * n2; i += gthreads) {
      const float* src; uint4* dst; int j;
      if (i < n1) { src = p.cwk; dst = (uint4*)(ws + OFF_CWKB); j = i; }
      else if (i < 2 * n1) { src = p.cwv; dst = (uint4*)(ws + OFF_CWVB); j = i - n1; }
      else if (i < 2 * n1 + n2) { src = p.cdk; dst = (uint4*)(ws + OFF_CDKB); j = i - 2 * n1; }
      else { src = p.cdv; dst = (uint4*)(ws + OFF_CDVB); j = i - 2 * n1 - n2; }
      float4 a = ((const float4*)src)[2 * j], bb = ((const float4*)src)[2 * j + 1];
      uint4 rr; rr.x = pk2(a.x, a.y); rr.y = pk2(a.z, a.w); rr.z = pk2(bb.x, bb.y); rr.w = pk2(bb.z, bb.w);
      dst[j] = rr;
    }
  }
  for (int i = gtid; i < DEPTH * 2 * 128 * 64 / 8; i += gthreads) {
    float4 a = ((const float4*)p.peer_keys)[2 * i], bb = ((const float4*)p.peer_keys)[2 * i + 1];
    uint4 rr; rr.x = pk2(a.x, a.y); rr.y = pk2(a.z, a.w); rr.z = pk2(bb.x, bb.y); rr.w = pk2(bb.z, bb.w);
    ((uint4*)(ws + OFF_KEYB))[i] = rr;
  }
  {
    float* rb = (float*)(ws + OFF_ROPEB);
    float* rc = (float*)(ws + OFF_ROPEC);
    for (int i = gtid; i < 1024 * 64; i += gthreads) {
      int pos = i >> 6, d = i & 63;
      float pv = (d < 32) ? (float)(pos >> 6) : (float)(pos & 63);
      float inv = powf(10000.f, -(float)(d & 15) / 16.f);
      float ang = pv * inv;
      rb[i] = cosf(ang);
      rb[1024 * 64 + i] = sinf(ang);
    }
    for (int i = gtid; i < 1024 * 32; i += gthreads) {
      int pos = i >> 5, d = i & 31;
      float pv = (d < 16) ? (float)(pos >> 6) : (float)(pos & 63);
      float inv = powf(10000.f, -(float)(d & 7) / 8.f);
      float ang = pv * inv;
      rc[i] = cosf(ang);
      rc[1024 * 32 + i] = sinf(ang);
    }
  }
  if (blockIdx.x == 0) { for (int i = tid; i < 2 * 32 * 512; i += NTHR) ((int*)(ws + OFF_QCTR))[i] = 0; }
  if (blockIdx.x == 0 && tid < DEPTH) {
    int l = tid;
    float s0 = 0.f, s1 = 0.f;
    for (int i = 0; i < 32; ++i) {
      s0 += p.lam_q[l * 64 + i] * p.lam_k[l * 64 + i];
      s1 += p.lam_q[l * 64 + 32 + i] * p.lam_k[l * 64 + 32 + i];
    }
    float lam_init = 0.8f - 0.6f * expf(-0.3f * (float)l);
    ((float*)(ws + OFF_LAM))[l] = expf(s0) - expf(s1) + lam_init;
    ((float*)(ws + OFF_LAM))[4 + l] = lam_init;
  }
}

DI void phase_modreduce(const Params& p) {
  const int gthreads = gridDim.x * NTHR;
  const int gtid = blockIdx.x * NTHR + threadIdx.x;
  const float* modp = (const float*)(p.ws + OFF_MODP);
  float* mod = (float*)(p.ws + OFF_MOD);
  for (int i = gtid; i < DEPTH * 3 * 6144; i += gthreads) {
    int l = i / (3 * 6144), r = i % (3 * 6144), n = r % 6144;
    float s = p.b_mod[l * 6144 + n];
#pragma unroll
    for (int ks = 0; ks < 16; ++ks) s += modp[((size_t)l * 16 + ks) * 3 * 6144 + r];
    mod[i] = s;
  }
}

DI void phase_ln0(const Params& p) {
  const int lane = threadIdx.x & 63;
  const int gw = blockIdx.x * 4 + (threadIdx.x >> 6), nw = gridDim.x * 4;
  float* X = (float*)(p.ws + OFF_X);
  bf16_t* H = (bf16_t*)(p.ws + OFF_H);
  const float* mod = (const float*)(p.ws + OFF_MOD);
  for (int t = gw; t < NT; t += nw) {
    const float* src = t < TCTX ? p.x_prompt + (size_t)t * DM : p.x_sample + (size_t)(t - TCTX) * DM;
    float v[16];
#pragma unroll
    for (int c = 0; c < 2; ++c) {
      const float4 a = ld_nt4(src + c * 512 + lane * 8), bq = ld_nt4(src + c * 512 + lane * 8 + 4);
      v[c * 8 + 0] = a.x; v[c * 8 + 1] = a.y; v[c * 8 + 2] = a.z; v[c * 8 + 3] = a.w;
      v[c * 8 + 4] = bq.x; v[c * 8 + 5] = bq.y; v[c * 8 + 6] = bq.z; v[c * 8 + 7] = bq.w;
    }
    store_row(X + (size_t)t * DM, lane, v);
    ln_mod_to_bf(v, mod + (size_t)(0 * 3 + tok_grp(t)) * 6144, 0, H + (size_t)t * DM, lane);
  }
}

DI void phase_ln1(const Grp& gr, const Params& p, int l, bool dry) {
  const int tid = opaque_tid();
  const int lane = tid & 63;
  const int gw = gr.lq * 4 + (tid >> 6), nw = gr.QB * 4;
  const float* X = (const float*)(p.ws + OFF_X);
  float* Xo = (float*)(p.ws + (dry ? OFF_X2 : OFF_X));
  bf16_t* H = (bf16_t*)(p.ws + (dry ? OFF_H2 : OFF_H));
  const float* mod = (const float*)(p.ws + OFF_MOD);
  for (int uq = gw; uq < QTOK; uq += nw) {
    const int t = tok_g(gr.g, gr.j * QTOK + uq);
    float v[16], g[16], b[16];
    load_row(X + (size_t)t * DM, lane, v);
    load_row(p.ln_g + (size_t)(l * 2 + 0) * DM, lane, g);
    load_row(p.ln_b + (size_t)(l * 2 + 0) * DM, lane, b);
    float mu, rstd;
    ln_stats(v, mu, rstd);
#pragma unroll
    for (int i = 0; i < 16; ++i) v[i] = (v[i] - mu) * rstd * g[i] + b[i];
    store_row(Xo + (size_t)t * DM, lane, v);
    ln_mod_to_bf(v, mod + (size_t)(l * 3 + tok_grp(t)) * 6144, 3072, H + (size_t)t * DM, lane);
  }
}

constexpr int GSTR = 72;
template <class Epi>
DI void gemm_phase(const Grp& gr, int nshard, const bf16_t* __restrict__ A, const bf16_t* __restrict__ Bt, int N, char* smem, int* ctr, Epi epi) {
  const int tid = opaque_tid(), lane = tid & 63, wave = tid >> 6;
  const int r = lane & 31, h = lane >> 5;
  const int wm = wave >> 1, wn = wave & 1;
  bf16_t* As = (bf16_t*)smem;
  bf16_t* Bs = As + 2 * 128 * GSTR;
  const int tiles_n = N >> 7;
  const int ntiles = 6 * tiles_n;
  bool qfirst = true;
  for (;;) {
    const int tile = next_tile_q(gr, ctr + gr.j * 64, smem, qfirst);
    if (tile >= ntiles) break;
    const int tn = tile % tiles_n, tm = mtile_g(gr.g, gr.j * 6 + tile / tiles_n);
    const int m0 = tm * 128, n0 = tn * 128;
    const bf16_t* Ap = A + (size_t)m0 * DM;
    const bf16_t* Bp = Bt + (size_t)n0 * DM;
    f32x16 acc[2][2];
#pragma unroll
    for (int i = 0; i < 2; ++i)
#pragma unroll
      for (int j = 0; j < 2; ++j)
#pragma unroll
        for (int e = 0; e < 16; ++e) acc[i][j][e] = 0.f;
    u32x4 ra0[4], rb0[4], ra1[4], rb1[4];
    const bf16_t* Ag = Ap + (size_t)(tid >> 3) * DM + (tid & 7) * 8;
    const bf16_t* Bg = Bp + (size_t)(tid >> 3) * DM + (tid & 7) * 8;
    const int lofs = (tid >> 3) * GSTR + (tid & 7) * 8;
#define G_LOAD(RA, RB, KT) { _Pragma("unroll") for (int i = 0; i < 4; ++i) { \
      RA[i] = *(const u32x4*)(Ag + (size_t)i * 32 * DM + (KT) * 64); RB[i] = *(const u32x4*)(Bg + (size_t)i * 32 * DM + (KT) * 64); } }
#define G_STORE(RA, RB, BUF) { _Pragma("unroll") for (int i = 0; i < 4; ++i) { \
      *(u32x4*)(As + (BUF) * 128 * GSTR + lofs + i * 32 * GSTR) = RA[i]; *(u32x4*)(Bs + (BUF) * 128 * GSTR + lofs + i * 32 * GSTR) = RB[i]; } }
#define G_FRAGS(SET, Ac, Bc, KS) { \
        fa0[SET] = *(const bf16x8*)(Ac + (wm * 64 + r) * GSTR + (KS) * 16 + h * 8); \
        fa1[SET] = *(const bf16x8*)(Ac + (wm * 64 + 32 + r) * GSTR + (KS) * 16 + h * 8); \
        fb0[SET] = *(const bf16x8*)(Bc + (wn * 64 + r) * GSTR + (KS) * 16 + h * 8); \
        fb1[SET] = *(const bf16x8*)(Bc + (wn * 64 + 32 + r) * GSTR + (KS) * 16 + h * 8); }
#define G_MFMAS(SET) { \
        acc[0][0] = MFMA(fa0[SET], fb0[SET], acc[0][0]); acc[0][1] = MFMA(fa0[SET], fb1[SET], acc[0][1]); \
        acc[1][0] = MFMA(fa1[SET], fb0[SET], acc[1][0]); acc[1][1] = MFMA(fa1[SET], fb1[SET], acc[1][1]); }
#define G_COMPUTE(BUF) { const bf16_t* Ac = As + (BUF) * 128 * GSTR; const bf16_t* Bc = Bs + (BUF) * 128 * GSTR; \
      bf16x8 fa0[2], fa1[2], fb0[2], fb1[2]; \
      G_FRAGS(0, Ac, Bc, 0); \
      __builtin_amdgcn_sched_barrier(0); \
      G_FRAGS(1, Ac, Bc, 1); \
      __builtin_amdgcn_sched_barrier(0); \
      G_MFMAS(0); \
      __builtin_amdgcn_sched_barrier(0); \
      G_FRAGS(0, Ac, Bc, 2); \
      __builtin_amdgcn_sched_barrier(0); \
      G_MFMAS(1); \
      __builtin_amdgcn_sched_barrier(0); \
      G_FRAGS(1, Ac, Bc, 3); \
      __builtin_amdgcn_sched_barrier(0); \
      G_MFMAS(0); \
      __builtin_amdgcn_sched_barrier(0); \
      G_MFMAS(1); \
      __builtin_amdgcn_sched_barrier(0); }
    G_LOAD(ra0, rb0, 0);
    G_LOAD(ra1, rb1, 1);
    G_STORE(ra0, rb0, 0);
    __syncthreads();
#pragma unroll 1
    for (int kt = 0; kt < 16; kt += 2) {
      if (kt + 2 < 16) G_LOAD(ra0, rb0, kt + 2);
      G_COMPUTE(0);
      G_STORE(ra1, rb1, 1);
      __syncthreads();
      if (kt + 3 < 16) G_LOAD(ra1, rb1, kt + 3);
      G_COMPUTE(1);
      if (kt + 2 < 16) G_STORE(ra0, rb0, 0);
      __syncthreads();
    }
#undef G_LOAD
#undef G_STORE
#undef G_COMPUTE
#undef G_FRAGS
#undef G_MFMAS
#pragma unroll
    for (int i = 0; i < 2; ++i)
#pragma unroll
      for (int j = 0; j < 2; ++j) epi(m0 + wm * 64 + i * 32, n0 + wn * 64 + j * 32, acc[i][j], r, h);
  }
}

constexpr int KSTR = 72;
constexpr int VSTR = 136;

struct AttnState { f32x16 o[2]; float m, l; };

DI void stage_k_bf(bf16_t* Ks, const bf16_t* src) {
  int tid = threadIdx.x;
  asm volatile("" : "+v"(tid));
#pragma unroll
  for (int i = 0; i < 4; ++i) {
    int id = tid + 256 * i, row = id >> 3, ch = id & 7;
    *(uint4*)(Ks + row * KSTR + ch * 8) = *(const uint4*)(src + (size_t)row * PC + ch * 8);
  }
}
DI void stage_k_f32(bf16_t* Ks, const float* src, int rstride) {
  int tid = threadIdx.x;
  asm volatile("" : "+v"(tid));
#pragma unroll
  for (int i = 0; i < 4; ++i) {
    int id = tid + 256 * i, row = id >> 3, ch = id & 7;
    const float* s = src + (size_t)row * rstride + ch * 8;
    float4 a = *(const float4*)s, b = *(const float4*)(s + 4);
    uint4 r; r.x = pk2(a.x, a.y); r.y = pk2(a.z, a.w); r.z = pk2(b.x, b.y); r.w = pk2(b.z, b.w);
    *(uint4*)(Ks + row * KSTR + ch * 8) = r;
  }
}
DI void stage_vt_bf(bf16_t* Vt, const bf16_t* src) {
  int tid = threadIdx.x;
  asm volatile("" : "+v"(tid));
#pragma unroll
  for (int i = 0; i < 4; ++i) {
    int id = tid + 256 * i, row = id & 127, ch = id >> 7;
    uint4 v = *(const uint4*)(src + (size_t)row * PC + ch * 8);
    unsigned w[4] = {v.x, v.y, v.z, v.w};
#pragma unroll
    for (int k = 0; k < 4; ++k) {
      Vt[(ch * 8 + 2 * k) * VSTR + row] = (bf16_t)(w[k] & 0xffffu);
      Vt[(ch * 8 + 2 * k + 1) * VSTR + row] = (bf16_t)(w[k] >> 16);
    }
  }
}
DI void stage_vt_f32(bf16_t* Vt, const float* src, int rstride) {
  int tid = threadIdx.x;
  asm volatile("" : "+v"(tid));
#pragma unroll
  for (int i = 0; i < 4; ++i) {
    int id = tid + 256 * i, row = id & 127, ch = id >> 7;
    const float* s = src + (size_t)row * rstride + ch * 8;
    float4 a = *(const float4*)s, b = *(const float4*)(s + 4);
    float f[8] = {a.x, a.y, a.z, a.w, b.x, b.y, b.z, b.w};
#pragma unroll
    for (int k = 0; k < 8; ++k) Vt[(ch * 8 + k) * VSTR + row] = f2bf(f[k]);
  }
}

template <int NKS>
DI void attn_tile(const bf16_t* Ks, int kcol0, const bf16_t* Vt, const bf16x8 (&qf)[NKS], AttnState& st, float cscale,
                  int maskmode, int qpos, int kpos0, int r, int h) {
  f32x16 s[2];
#pragma unroll
  for (int kb = 0; kb < 2; ++kb) {
#pragma unroll
    for (int e = 0; e < 16; ++e) s[kb][e] = 0.f;
#pragma unroll
    for (int ks = 0; ks < NKS; ++ks) {
      bf16x8 a = *(const bf16x8*)(Ks + (kb * 32 + r) * KSTR + kcol0 + ks * 16 + h * 8);
      s[kb] = MFMA(a, qf[ks], s[kb]);
    }
  }
  float tmax = -INFINITY;
#pragma unroll
  for (int kb = 0; kb < 2; ++kb)
#pragma unroll
    for (int e = 0; e < 16; ++e) {
      float v = s[kb][e] * cscale;
      if (maskmode) {
        int kp = kpos0 + kb * 32 + crow(e, h);
        int dd = kp - qpos; dd = dd < 0 ? -dd : dd;
        v = (dd <= 128) ? v : -INFINITY;
      }
      s[kb][e] = v;
      tmax = fmaxf(tmax, v);
    }
  tmax = fmaxf(tmax, __shfl_xor(tmax, 32));
  float mnew = fmaxf(st.m, tmax);
  float alpha = (mnew == -INFINITY) ? 1.f : __builtin_amdgcn_exp2f(st.m - mnew);
  float msub = (mnew == -INFINITY) ? 0.f : mnew;
  float psum = 0.f;
#pragma unroll
  for (int kb = 0; kb < 2; ++kb)
#pragma unroll
    for (int e = 0; e < 16; ++e) {
      float pv = __builtin_amdgcn_exp2f(s[kb][e] - msub);
      s[kb][e] = pv;
      psum += pv;
    }
  st.l = st.l * alpha + psum;
  st.m = mnew;
#pragma unroll
  for (int db = 0; db < 2; ++db)
#pragma unroll
    for (int e = 0; e < 16; ++e) st.o[db][e] *= alpha;
#pragma unroll
  for (int kb = 0; kb < 2; ++kb)
#pragma unroll
    for (int ss = 0; ss < 2; ++ss) {
      uint4 pu;
      pu.x = pk2(s[kb][8 * ss + 0], s[kb][8 * ss + 1]);
      pu.y = pk2(s[kb][8 * ss + 2], s[kb][8 * ss + 3]);
      pu.z = pk2(s[kb][8 * ss + 4], s[kb][8 * ss + 5]);
      pu.w = pk2(s[kb][8 * ss + 6], s[kb][8 * ss + 7]);
      bf16x8 pb = as_bf16x8(pu);
#pragma unroll
      for (int db = 0; db < 2; ++db) {
        const bf16_t* vp = Vt + (db * 32 + r) * VSTR + kb * 32 + 16 * ss + 4 * h;
        s16x4 lo = *(const s16x4*)vp;
        s16x4 hi = *(const s16x4*)(vp + 8);
        bf16x8 va = __builtin_shufflevector(lo, hi, 0, 1, 2, 3, 4, 5, 6, 7);
        st.o[db] = MFMA(va, pb, st.o[db]);
      }
    }
}

DI void store_oT(bf16_t* O, int token, int colbase, const f32x16 (&o)[2], int h) {
#pragma unroll
  for (int db = 0; db < 2; ++db)
#pragma unroll
    for (int g = 0; g < 4; ++g) {
      uint2 u;
      u.x = pk2(o[db][4 * g + 0], o[db][4 * g + 1]);
      u.y = pk2(o[db][4 * g + 2], o[db][4 * g + 3]);
      *(uint2*)(O + (size_t)token * DM + colbase + db * 32 + 8 * g + 4 * h) = u;
    }
}

DI void attn_init(AttnState& st, float m0, float l0) {
#pragma unroll
  for (int db = 0; db < 2; ++db)
#pragma unroll
    for (int e = 0; e < 16; ++e) st.o[db][e] = 0.f;
  st.m = m0;
  st.l = l0;
}

DI void mixer_bc(const Params& p, int l, bool isC, bool lat, int b, int hd, int qb, char* smem) {
  const int tid = opaque_tid(), lane = tid & 63, wave = tid >> 6, r = lane & 31, h = lane >> 5;
  const int qblk = wave >> 1, role = wave & 1;
  const int hdw = isC ? hd : (hd & ~1) + role;
  bf16_t* Ks = (bf16_t*)smem;
  bf16_t* Vt = Ks + 128 * KSTR;
  float* xch = (float*)smem;
  const bf16_t* P = (const bf16_t*)(p.ws + OFF_P);
  const int kv = hd >> 1;
  const int seq0 = lat ? TCTX + b * 1024 : b * 256;
  const int qpos = qb * 64 + qblk * 32 + r;
  const int qtok = seq0 + qpos;
  const float LOG2E = 1.4426950408889634f;
  bf16x8 qf[4];
  {
    const int qcol = isC ? 1024 + hd * 64 + role * 32 : 512 + hdw * 64;
    const bf16_t* qp = P + (size_t)qtok * PC + qcol + h * 8;
    qf[0] = *(const bf16x8*)(qp);
    qf[1] = *(const bf16x8*)(qp + 16);
    qf[2] = qf[0]; qf[3] = qf[1];
    if (!isC) { qf[2] = *(const bf16x8*)(qp + 32); qf[3] = *(const bf16x8*)(qp + 48); }
  }
  const float cscale = isC ? 0.17677669529663687f * LOG2E : 0.125f * LOG2E;
  AttnState st;
  if (isC) attn_init(st, -INFINITY, 0.f);
  else attn_init(st, p.win_sink[l * 4 + hdw] * LOG2E, (h == 0) ? 1.f : 0.f);
  const int ntile = isC ? (lat ? 10 : 2) : (lat ? 5 : 2);
  const int band0 = (qb >> 1) - 1;
  u32x4 kreg[4], vreg[4];
  auto tile_exists = [&](int ti) -> bool {
    if (!isC && lat && ti < 3) { int kt = band0 + ti; return kt >= 0 && kt < 8; }
    return true;
  };
  auto tile_load = [&](int ti) {
    const bf16_t *kp, *vp; int stride;
    if (isC) {
      if (lat && ti < 2) {
        const size_t off = ((size_t)(b * DEPTH + l) * 256 + ti * 128) * 256 + hd * 64;
        kp = (const bf16_t*)(p.ws + OFF_CDKB) + off; vp = (const bf16_t*)(p.ws + OFF_CDVB) + off; stride = 256;
      } else {
        const int kt = lat ? ti - 2 : ti;
        const bf16_t* base = P + (size_t)(seq0 + kt * 128) * PC;
        kp = base + 1280 + hd * 64; vp = base + 1536 + hd * 64; stride = PC;
      }
    } else {
      if (lat && ti >= 3) {
        const size_t off = ((size_t)(b * DEPTH + l) * 256 + (ti - 3) * 128) * 128 + kv * 64;
        kp = (const bf16_t*)(p.ws + OFF_CWKB) + off; vp = (const bf16_t*)(p.ws + OFF_CWVB) + off; stride = 128;
      } else {
        const int kt = lat ? band0 + ti : ti;
        const bf16_t* base = P + (size_t)(seq0 + kt * 128) * PC;
        kp = base + 768 + kv * 64; vp = base + 896 + kv * 64; stride = PC;
      }
    }
    int t2 = tid;
    asm volatile("" : "+v"(t2));
#pragma unroll
    for (int i = 0; i < 4; ++i) {
      int id = t2 + 256 * i;
      kreg[i] = *(const u32x4*)(kp + (size_t)(id >> 3) * stride + (id & 7) * 8);
      vreg[i] = *(const u32x4*)(vp + (size_t)(id & 127) * stride + (id >> 7) * 8);
    }
  };
  auto tile_store = [&]() {
    int t2 = tid;
    asm volatile("" : "+v"(t2));
#pragma unroll
    for (int i = 0; i < 4; ++i) {
      int id = t2 + 256 * i;
      *(u32x4*)(Ks + (id >> 3) * KSTR + (id & 7) * 8) = kreg[i];
      const int row = id & 127, ch = id >> 7;
#pragma unroll
      for (int k = 0; k < 4; ++k) {
        Vt[(ch * 8 + 2 * k) * VSTR + row] = (bf16_t)(vreg[i][k] & 0xffffu);
        Vt[(ch * 8 + 2 * k + 1) * VSTR + row] = (bf16_t)(vreg[i][k] >> 16);
      }
    }
  };
  if (tile_exists(0)) tile_load(0);
#pragma unroll 1
  for (int ti = 0; ti < ntile; ++ti) {
    const bool ex = tile_exists(ti);
    __syncthreads();
    if (ex) tile_store();
    __syncthreads();
    if (ti + 1 < ntile && tile_exists(ti + 1)) tile_load(ti + 1);
    if (ex) {
      if (isC) {
        const bf16x8 q2[2] = {qf[0], qf[1]};
#pragma unroll 1
        for (int hf = 0; hf < 2; ++hf)
          attn_tile<2>(Ks + hf * 64 * KSTR, role * 32, Vt + hf * 64, q2, st, cscale, 0, 0, 0, r, h);
      } else {
        const bool band = lat && ti < 3;
#pragma unroll 1
        for (int hf = 0; hf < 2; ++hf)
          attn_tile<4>(Ks + hf * 64 * KSTR, 0, Vt + hf * 64, qf, st, cscale, band ? 1 : 0, qpos, (band0 + ti) * 128 + hf * 64, r, h);
      }
    }
  }
  if (!isC) {
    const float inv = 1.f / (st.l + __shfl_xor(st.l, 32));
#pragma unroll
    for (int db = 0; db < 2; ++db)
#pragma unroll
      for (int e = 0; e < 16; ++e) st.o[db][e] *= inv;
    store_oT((bf16_t*)(p.ws + OFF_O), qtok, 256 + hdw * 64, st.o, h);
    return;
  }
  __syncthreads();
  float* xp = xch + (size_t)(qblk * 64 + lane) * 36;
  if (role == 1) {
#pragma unroll
    for (int db = 0; db < 2; ++db)
#pragma unroll
      for (int g = 0; g < 4; ++g)
        *(float4*)(xp + db * 16 + g * 4) = make_float4(st.o[db][4 * g], st.o[db][4 * g + 1], st.o[db][4 * g + 2], st.o[db][4 * g + 3]);
    xp[32] = st.m; xp[33] = st.l;
  }
  __syncthreads();
  if (role == 0) {
    f32x16 o1[2];
#pragma unroll
    for (int db = 0; db < 2; ++db)
#pragma unroll
      for (int g = 0; g < 4; ++g) {
        float4 v = *(const float4*)(xp + db * 16 + g * 4);
        o1[db][4 * g] = v.x; o1[db][4 * g + 1] = v.y; o1[db][4 * g + 2] = v.z; o1[db][4 * g + 3] = v.w;
      }
    const float m1 = xp[32], l1 = xp[33];
    if (isC) {
      const float lam = ((const float*)(p.ws + OFF_LAM))[l];
      const float lam_init = ((const float*)(p.ws + OFF_LAM))[4 + l];
      float i0 = 1.f / (st.l + __shfl_xor(st.l, 32));
      float i1 = lam / (l1 + __shfl_xor(l1, 32));
      float ss = 0.f;
#pragma unroll
      for (int db = 0; db < 2; ++db)
#pragma unroll
        for (int e = 0; e < 16; ++e) {
          float w = st.o[db][e] * i0 - o1[db][e] * i1;
          st.o[db][e] = w;
          ss += w * w;
        }
      ss += __shfl_xor(ss, 32);
      float rs = rsqrtf(ss * (1.f / 64.f) + LN_EPS) * (1.f - lam_init);
#pragma unroll
      for (int db = 0; db < 2; ++db)
#pragma unroll
        for (int e = 0; e < 16; ++e) st.o[db][e] *= rs * p.subln_g[l * 64 + db * 32 + crow(e, h)];
      store_oT((bf16_t*)(p.ws + OFF_O), qtok, 512 + hd * 64, st.o, h);
    } else {
      const float m = fmaxf(st.m, m1);
      const float a0 = __builtin_amdgcn_exp2f(st.m - m), a1 = __builtin_amdgcn_exp2f(m1 - m);
      float lt = st.l * a0 + l1 * a1;
      lt += __shfl_xor(lt, 32);
      const float inv = 1.f / lt;
      const float c0 = a0 * inv, c1 = a1 * inv;
#pragma unroll
      for (int db = 0; db < 2; ++db)
#pragma unroll
        for (int e = 0; e < 16; ++e) st.o[db][e] = st.o[db][e] * c0 + o1[db][e] * c1;
      store_oT((bf16_t*)(p.ws + OFF_O), qtok, 256 + hd * 64, st.o, h);
    }
  }
}

DI void mixer_a(const Params& p, int l, int ch, int hd, char* smem) {
  const int tid = opaque_tid(), lane = tid & 63, wave = tid >> 6, r = lane & 31, h = lane >> 5;
  bf16_t* Vt = (bf16_t*)smem;
  const bf16_t* P = (const bf16_t*)(p.ws + OFF_P);
  const int tok0 = ch * 128;
  __syncthreads();
  stage_vt_bf(Vt, P + (size_t)tok0 * PC + 256 + hd * 64);
  __syncthreads();
  const int pp = wave * 32 + r;
  const float* wrow = p.chunk_w + ((size_t)(l * 4 + hd) * 128 + pp) * 128;
  f32x16 acc[2];
#pragma unroll
  for (int db = 0; db < 2; ++db)
#pragma unroll
    for (int e = 0; e < 16; ++e) acc[db][e] = 0.f;
#pragma unroll
  for (int ks = 0; ks < 8; ++ks) {
    float4 a = *(const float4*)(wrow + ks * 16 + 8 * h), b = *(const float4*)(wrow + ks * 16 + 8 * h + 4);
    uint4 wu; wu.x = pk2(a.x, a.y); wu.y = pk2(a.z, a.w); wu.z = pk2(b.x, b.y); wu.w = pk2(b.z, b.w);
    bf16x8 wb = as_bf16x8(wu);
#pragma unroll
    for (int db = 0; db < 2; ++db) {
      bf16x8 va = *(const bf16x8*)(Vt + (db * 32 + r) * VSTR + ks * 16 + 8 * h);
      acc[db] = MFMA(va, wb, acc[db]);
    }
  }
  const float bias = p.chunk_b[(l * 4 + hd) * 128 + pp];
  const int token = tok0 + pp;
#pragma unroll
  for (int db = 0; db < 2; ++db)
#pragma unroll
    for (int g = 0; g < 4; ++g) {
      uint2 uu = *(const uint2*)(P + (size_t)token * PC + hd * 64 + db * 32 + 8 * g + 4 * h);
      acc[db][4 * g + 0] = bflo(uu.x) * (acc[db][4 * g + 0] + bias);
      acc[db][4 * g + 1] = bfhi(uu.x) * (acc[db][4 * g + 1] + bias);
      acc[db][4 * g + 2] = bflo(uu.y) * (acc[db][4 * g + 2] + bias);
      acc[db][4 * g + 3] = bfhi(uu.y) * (acc[db][4 * g + 3] + bias);
    }
  store_oT((bf16_t*)(p.ws + OFF_O), token, hd * 64, acc, h);
}

DI void mixer_d(const Params& p, int l, int ch, int g) {
  const int tid = opaque_tid(), lane = tid & 63, wave = tid >> 6, r = lane & 31, h = lane >> 5;
  const bf16_t* P = (const bf16_t*)(p.ws + OFF_P);
  const int token = ch * 128 + wave * 32 + r;
  int s0, slen;
  if (token < TCTX) { s0 = token & ~255; slen = 256; } else { s0 = TCTX + ((token - TCTX) & ~1023); slen = 1024; }
  const int pos = token - s0;
  const int w = 2 << g, hw = w >> 1;
  int lo = pos - hw; if (lo < 0) lo = 0;
  int hi = pos + hw; if (hi > slen) hi = slen;
  const float icnt = 1.f / (float)(hi - lo);
  const float* wp = p.pool_w + (size_t)(l * 4 + g) * 64 * 64;
  f32x16 acc[2];
#pragma unroll
  for (int db = 0; db < 2; ++db)
#pragma unroll
    for (int e = 0; e < 16; ++e) acc[db][e] = 0.f;
#pragma unroll
  for (int ks = 0; ks < 4; ++ks) {
    const int cbase = 1792 + g * 64 + ks * 16 + 8 * h;
    float sum[8];
#pragma unroll
    for (int k = 0; k < 8; ++k) sum[k] = 0.f;
    for (int i = 0; i < w; ++i) {
      int tt = pos - hw + i;
      if (tt >= 0 && tt < slen) {
        uint4 v = *(const uint4*)(P + (size_t)(s0 + tt) * PC + cbase);
        sum[0] += bflo(v.x); sum[1] += bfhi(v.x); sum[2] += bflo(v.y); sum[3] += bfhi(v.y);
        sum[4] += bflo(v.z); sum[5] += bfhi(v.z); sum[6] += bflo(v.w); sum[7] += bfhi(v.w);
      }
    }
    uint4 zv = *(const uint4*)(P + (size_t)token * PC + cbase);
    float z[8] = {bflo(zv.x), bfhi(zv.x), bflo(zv.y), bfhi(zv.y), bflo(zv.z), bfhi(zv.z), bflo(zv.w), bfhi(zv.w)};
    float pl[8];
#pragma unroll
    for (int k = 0; k < 8; ++k) pl[k] = sum[k] * icnt - z[k];
    bf16x8 pb = as_bf16x8(pack8(pl));
#pragma unroll
    for (int db = 0; db < 2; ++db) {
      float wv[8];
#pragma unroll
      for (int k = 0; k < 8; ++k) wv[k] = wp[(ks * 16 + 8 * h + k) * 64 + db * 32 + r];
      bf16x8 wa = as_bf16x8(pack8(wv));
      acc[db] = MFMA(wa, pb, acc[db]);
    }
  }
#pragma unroll
  for (int db = 0; db < 2; ++db)
#pragma unroll
    for (int e = 0; e < 16; ++e) acc[db][e] *= p.pool_scale[l * 256 + g * 64 + db * 32 + crow(e, h)];
  store_oT((bf16_t*)(p.ws + OFF_O), token, 768 + g * 64, acc, h);
}

DI void phase_mixers(const Grp& gr, int nshard, const Params& p, int l, char* smem, int* ctr) {
  bool qfirst = true;
  for (;;) {
    const int it = next_item(gr, ctr, smem, qfirst, nshard);
    if (it >= 480) break;
    if (it < 288) {
      bool lat, cmix; int b, hd, qb;
      if (it < 64) { int q = it; lat = true; cmix = true; b = gr.g; hd = (q >> 4) & 3; qb = q & 15; }
      else if (it < 96) { int q = it - 64; lat = true; cmix = false; b = gr.g; hd = ((q >> 4) & 1) * 2; qb = q & 15; }
      else if (it < 224) { int q = it - 96; lat = false; cmix = true; b = gr.g * 8 + (q >> 4); hd = (q >> 2) & 3; qb = q & 3; }
      else { int q = it - 224; lat = false; cmix = false; b = gr.g * 8 + (q >> 3); hd = ((q >> 2) & 1) * 2; qb = q & 3; }
      mixer_bc(p, l, cmix, lat, b, hd, qb, smem);
    } else if (it < 384) { int q = it - 288; mixer_a(p, l, mtile_g(gr.g, q >> 2), q & 3, smem); }
    else { int q = it - 384; mixer_d(p, l, mtile_g(gr.g, q >> 2), q & 3); }
  }
}

constexpr int PKSTR = 68;
constexpr int PKJ = 128 * PKSTR + 16;

typedef float f32x4 __attribute__((ext_vector_type(4)));
DI void phase_peer(const Grp& gr, const Params& p, int l, char* smem, bool dry) {
  const int tid = opaque_tid(), lane = tid & 63, wave = tid >> 6;
  unsigned* scr3 = (unsigned*)smem + wave * 1024;
  unsigned* eidx = scr3 + 768;
  float* egate = (float*)(scr3 + 896);
  __syncthreads();
  int ci = 0, cj = 0;
  {
    int L = lane, i = 0;
    while (i < 16 && L >= 16 / (i + 1)) { L -= 16 / (i + 1); ++i; }
    ci = i; cj = L;
  }
  const bool cvalid = lane < 50;
  if (!cvalid) { ci = 0; cj = 0; }
  const float* X = (const float*)(p.ws + OFF_X);
  float* Xw = (float*)(p.ws + (dry ? OFF_X2 : OFF_X));
  const bf16_t* Qb = (const bf16_t*)(p.ws + OFF_Q);
  const bf16_t* KB = (const bf16_t*)(p.ws + OFF_KEYB) + (size_t)l * 2 * 128 * 64;
  const bf16_t* H = (const bf16_t*)(p.ws + OFF_H);
  bf16_t* Hw = (bf16_t*)(p.ws + (dry ? OFF_H2 : OFF_H));
  float* Yw = dry ? (float*)(p.ws + OFF_X2) : p.out + OUT_Y;
  const float* mod = (const float*)(p.ws + OFF_MOD);
  const unsigned char* U8 = (const unsigned char*)(p.ws + OFF_UB) + (size_t)l * NEXP * 2048;
  const unsigned char* V8 = U8 + 1024;
  const float* USC = (const float*)(p.ws + OFF_USC) + (size_t)l * NEXP;
  const float* VSC = (const float*)(p.ws + OFF_VSC) + (size_t)l * NEXP;
  const int gw = gr.lq * 4 + wave, nw = gr.QB * 4;
  const int q0 = gr.j * QTOK;
#pragma unroll 1
  for (int tb = gw; tb < QTOK; tb += 3 * nw) {
    {
      const int c16 = lane & 15, quad = lane >> 4;
#pragma unroll 1
      for (int jc = 0; jc < 4; ++jc) {
        const int j = jc >> 1, c = (jc & 1) * 16 + c16;
        int ti = c >> 3; if (ti > 2) ti = 2;
        const int hh = c & 7;
        int tok = tb + ti * nw; if (tok >= QTOK) tok = tb;
        tok = tok_g(gr.g, q0 + tok);
        const bf16_t* qp = Qb + (size_t)tok * DM + hh * 128 + j * 64 + quad * 8;
        const bf16x8 b0 = *(const bf16x8*)qp, b1 = *(const bf16x8*)(qp + 32);
        const bf16_t* kp = KB + (size_t)(j * 128 + c16) * 64 + quad * 8;
        float top[16];
#pragma unroll
        for (int s = 0; s < 16; ++s) top[s] = -3.0e38f;
#pragma unroll
        for (int nb = 0; nb < 8; ++nb) {
          const bf16x8 a0 = *(const bf16x8*)(kp + nb * 16 * 64), a1 = *(const bf16x8*)(kp + nb * 16 * 64 + 32);
          f32x4 acc = {0.f, 0.f, 0.f, 0.f};
          acc = __builtin_amdgcn_mfma_f32_16x16x32_bf16(a0, b0, acc, 0, 0, 0);
          acc = __builtin_amdgcn_mfma_f32_16x16x32_bf16(a1, b1, acc, 0, 0, 0);
#pragma unroll
          for (int e = 0; e < 4; ++e) {
            float v = __uint_as_float((__float_as_uint(acc[e]) & ~0x7Fu) | (unsigned)(nb * 16 + quad * 4 + e));
#pragma unroll
            for (int s = 0; s < 16; ++s) {
              float hi_ = fmaxf(top[s], v);
              v = fminf(top[s], v);
              top[s] = hi_;
            }
          }
        }
#pragma unroll
        for (int step = 16; step <= 32; step <<= 1) {
          float oth[16];
#pragma unroll
          for (int s = 0; s < 16; ++s) oth[s] = __shfl_xor(top[s], step);
#pragma unroll
          for (int s = 0; s < 16; ++s) top[s] = fmaxf(top[s], oth[15 - s]);
#pragma unroll
          for (int dist = 8; dist >= 1; dist >>= 1) {
#pragma unroll
            for (int s = 0; s < 16; ++s) {
              if ((s & dist) == 0) {
                float a = top[s], b = top[s + dist];
                top[s] = fmaxf(a, b);
                top[s + dist] = fminf(a, b);
              }
            }
          }
        }
        if (quad == 0 && c < 24) {
          unsigned* dstp = scr3 + ((c >> 3) * 16 + 2 * hh + j) * 16;
#pragma unroll
          for (int s4 = 0; s4 < 4; ++s4)
            *(uint4*)(dstp + s4 * 4) = make_uint4(__float_as_uint(top[s4 * 4 + 0]), __float_as_uint(top[s4 * 4 + 1]),
                                                  __float_as_uint(top[s4 * 4 + 2]), __float_as_uint(top[s4 * 4 + 3]));
        }
      }
    }
    __builtin_amdgcn_fence(__ATOMIC_RELEASE, "wavefront");
    __builtin_amdgcn_wave_barrier();
    __builtin_amdgcn_fence(__ATOMIC_ACQUIRE, "wavefront");
#pragma unroll 1
    for (int ti3 = 0; ti3 < 3; ++ti3) {
    if (tb + ti3 * nw >= QTOK) break;
    const int t = tok_g(gr.g, q0 + tb + ti3 * nw);
    unsigned* scr = scr3 + ti3 * 256;
    for (int hd = 0; hd < 8; ++hd) {
      unsigned ka = scr[(2 * hd) * 16 + ci], kb = scr[(2 * hd + 1) * 16 + cj];
      float cand = cvalid ? (__uint_as_float(ka & ~0x7Fu) + __uint_as_float(kb & ~0x7Fu)) : -3.0e38f;
      int rank = 0;
#pragma unroll
      for (int m = 0; m < 50; ++m) {
        float sv = __uint_as_float(__builtin_amdgcn_readlane(__float_as_uint(cand), m));
        rank += (sv > cand) ? 1 : 0;
      }
      bool sel = cvalid && rank < 16;
      unsigned long long bm = __ballot(sel);
      int slot = __builtin_amdgcn_mbcnt_hi((unsigned)(bm >> 32), __builtin_amdgcn_mbcnt_lo((unsigned)bm, 0));
      unsigned long long b0 = __ballot(cvalid && rank == 0);
      int l0 = __ffsll((long long)b0) - 1;
      float mx = __uint_as_float(__builtin_amdgcn_readlane(__float_as_uint(cand), l0));
      float e = sel ? __expf(cand - mx) : 0.f;
      float sum = wave_sum(e);
      if (sel && slot < 16) {
        eidx[hd * 16 + slot] = (ka & 0x7Fu) * 128u + (kb & 0x7Fu);
        egate[hd * 16 + slot] = e / sum;
      }
    }
    __builtin_amdgcn_fence(__ATOMIC_RELEASE, "wavefront");
    __builtin_amdgcn_wave_barrier();
    __builtin_amdgcn_fence(__ATOMIC_ACQUIRE, "wavefront");
    const float* modv = mod + (size_t)(l * 3 + tok_grp(t)) * 6144;
    f2v_t h2[8], outp[8];
    {
#pragma unroll
      for (int j = 0; j < 4; ++j) {
        const uint2 hu = *(const uint2*)(H + (size_t)t * DM + j * 256 + lane * 4);
        h2[2 * j] = f2v_t{bflo(hu.x), bfhi(hu.x)};
        h2[2 * j + 1] = f2v_t{bflo(hu.y), bfhi(hu.y)};
      }
#pragma unroll
      for (int w = 0; w < 8; ++w) outp[w] = f2v_t{0.f, 0.f};
    }
    {
      float* eus = (float*)scr;
#pragma unroll
      for (int j = 0; j < 2; ++j) {
        const int i = lane + 64 * j;
        const unsigned id = eidx[i];
        eus[i] = USC[id];
        eus[128 + i] = egate[i] * VSC[id];
      }
    }
    __builtin_amdgcn_fence(__ATOMIC_RELEASE, "wavefront");
    __builtin_amdgcn_wave_barrier();
    __builtin_amdgcn_fence(__ATOMIC_ACQUIRE, "wavefront");
    const float* eus = (const float*)scr;
    u32x4 ub[16], vb[16];
#pragma unroll 1
    for (int hd = 0; hd < 8; ++hd) {
#pragma unroll
      for (int k = 0; k < 16; ++k) {
        unsigned id = __builtin_amdgcn_readfirstlane(eidx[hd * 16 + k]);
        ub[k] = *(const u32x4*)(U8 + ((size_t)id << 11) + lane * 16);
      }
#pragma unroll
      for (int k = 0; k < 16; ++k) {
        unsigned id = __builtin_amdgcn_readfirstlane(eidx[hd * 16 + k]);
        vb[k] = *(const u32x4*)(V8 + ((size_t)id << 11) + lane * 16);
      }
      float pd[16];
#pragma unroll
      for (int k = 0; k < 16; ++k) {
        f2v_t acc = {0.f, 0.f};
#pragma unroll
        for (int w = 0; w < 4; ++w) {
          acc = __builtin_elementwise_fma(__builtin_amdgcn_cvt_pk_f32_fp8((int)ub[k][w], false), h2[2 * w], acc);
          acc = __builtin_elementwise_fma(__builtin_amdgcn_cvt_pk_f32_fp8((int)ub[k][w], true), h2[2 * w + 1], acc);
        }
        pd[k] = acc.x + acc.y;
      }
      const bool b0 = lane & 1, b1 = lane & 2, b2 = lane & 4, b3 = lane & 8;
      float w8[8], w4[4], w2[2], z;
#pragma unroll
      for (int i = 0; i < 8; ++i) { float snd = b0 ? pd[i] : pd[8 + i], kp = b0 ? pd[8 + i] : pd[i]; w8[i] = kp + __shfl_xor(snd, 1); }
#pragma unroll
      for (int i = 0; i < 4; ++i) { float snd = b1 ? w8[i] : w8[4 + i], kp = b1 ? w8[4 + i] : w8[i]; w4[i] = kp + __shfl_xor(snd, 2); }
#pragma unroll
      for (int i = 0; i < 2; ++i) { float snd = b2 ? w4[i] : w4[2 + i], kp = b2 ? w4[2 + i] : w4[i]; w2[i] = kp + __shfl_xor(snd, 4); }
      { float snd = b3 ? w2[0] : w2[1], kp = b3 ? w2[1] : w2[0]; z = kp + __shfl_xor(snd, 8); }
      z += __shfl_xor(z, 16); z += __shfl_xor(z, 32);
      const int kmine = ((lane & 1) << 3) | ((lane & 2) << 1) | ((lane & 4) >> 1) | ((lane & 8) >> 3);
      const float cfl = eus[128 + hd * 16 + kmine] * gelu_t(z * eus[hd * 16 + kmine]);
#pragma unroll
      for (int k = 0; k < 16; ++k) {
        const int src = ((k >> 3) & 1) | (((k >> 2) & 1) << 1) | (((k >> 1) & 1) << 2) | ((k & 1) << 3);
        const float cf = __uint_as_float(__builtin_amdgcn_readlane(__float_as_uint(cfl), src));
        const f2v_t c2 = {cf, cf};
#pragma unroll
        for (int w = 0; w < 4; ++w) {
          outp[2 * w] = __builtin_elementwise_fma(__builtin_amdgcn_cvt_pk_f32_fp8((int)vb[k][w], false), c2, outp[2 * w]);
          outp[2 * w + 1] = __builtin_elementwise_fma(__builtin_amdgcn_cvt_pk_f32_fp8((int)vb[k][w], true), c2, outp[2 * w + 1]);
        }
      }
    }
    float x1[16], outv[16];
#pragma unroll
    for (int w = 0; w < 8; ++w) { outv[2 * w] = outp[w].x; outv[2 * w + 1] = outp[w].y; }
    load_row16(X + (size_t)t * DM, lane, x1);
    {
      float g2[16], g[16], bb[16];
      load_row16(modv + 5120, lane, g2);
      load_row16(p.ln_g + (size_t)(l * 2 + 1) * DM, lane, g);
      load_row16(p.ln_b + (size_t)(l * 2 + 1) * DM, lane, bb);
#pragma unroll
      for (int i = 0; i < 16; ++i) x1[i] = ALPHA * x1[i] + g2[i] * outv[i];
      float mu, rstd;
      ln_stats(x1, mu, rstd);
#pragma unroll
      for (int i = 0; i < 16; ++i) x1[i] = (x1[i] - mu) * rstd * g[i] + bb[i];
      if (l == DEPTH - 1) {
        {
          typedef float f32x4s __attribute__((ext_vector_type(4)));
#pragma unroll
          for (int j = 0; j < 4; ++j) {
            const f32x4s tv = {x1[4 * j], x1[4 * j + 1], x1[4 * j + 2], x1[4 * j + 3]};
            __builtin_nontemporal_store(tv, (f32x4s*)(Yw + (size_t)t * DM + j * 256 + lane * 4));
          }
        }
      } else {
        store_row16(Xw + (size_t)t * DM, lane, x1);
        const float* modn = mod + (size_t)((l + 1) * 3 + tok_grp(t)) * 6144;
        ln_stats(x1, mu, rstd);
        float sh[16], scv[16];
        load_row16(modn, lane, sh);
        load_row16(modn + 1024, lane, scv);
#pragma unroll
        for (int i = 0; i < 16; ++i) x1[i] = (x1[i] - mu) * rstd * (1.f + scv[i]) + sh[i];
#pragma unroll
        for (int j = 0; j < 4; ++j) {
          uint2 hu; hu.x = pk2(x1[4 * j], x1[4 * j + 1]); hu.y = pk2(x1[4 * j + 2], x1[4 * j + 3]);
          *(uint2*)(Hw + (size_t)t * DM + j * 256 + lane * 4) = hu;
        }
      }
    }
    }
  }
}

struct EpiG1 {
  const Params* p; int l;
  DI void operator()(int rb, int cb, const f32x16& acc, int r, int h) const {
    bf16_t* P = (bf16_t*)(p->ws + OFF_P);
    const int col = cb + r;
    const bool lat = rb >= TCTX;
    float v[16];
#pragma unroll
    for (int e = 0; e < 16; ++e) v[e] = acc[e];
    if (cb < 512) {
#pragma unroll
      for (int e = 0; e < 16; ++e) v[e] = gelu_t(v[e]);
    } else if (lat) {
      const bool ropeB = (cb < 896);
      const bool ropeC = (cb >= 1024 && cb < 1536);
      if (ropeB || ropeC) {
        const int dim = ropeB ? 64 : 32, q = ropeB ? 16 : 8;
        const float* tab = (const float*)(p->ws + (ropeB ? OFF_ROPEB : OFF_ROPEC));
        const int di = col & (dim - 1);
        const bool up = (di & q) != 0;
#pragma unroll
        for (int e = 0; e < 16; ++e) {
          int pos = (rb + crow(e, h) - TCTX) & 1023;
          float partner = __shfl_xor(v[e], q);
          float cs = tab[pos * dim + di], sn = tab[1024 * dim + pos * dim + di];
          v[e] = v[e] * cs + (up ? partner : -partner) * sn;
        }
      }
    }
#pragma unroll
    for (int e = 0; e < 16; ++e) P[(size_t)(rb + crow(e, h)) * PC + col] = f2bf(v[e]);
    if (!lat) {
      float* dst = nullptr; int width = 0, c0 = 0;
      if (cb >= 768 && cb < 896) { dst = p->out + OUT_WK; width = 128; c0 = 768; }
      else if (cb >= 896 && cb < 1024) { dst = p->out + OUT_WV; width = 128; c0 = 896; }
      else if (cb >= 1280 && cb < 1536) { dst = p->out + OUT_DK; width = 256; c0 = 1280; }
      else if (cb >= 1536 && cb < 1792) { dst = p->out + OUT_DV; width = 256; c0 = 1536; }
      if (dst) {
#pragma unroll
        for (int e = 0; e < 16; ++e) {
          int t = rb + crow(e, h), b = t >> 8, s = t & 255;
          __builtin_nontemporal_store(v[e], &dst[((size_t)(b * DEPTH + l) * 256 + s) * width + (col - c0)]);
        }
      }
    }
  }
};
struct EpiG2 {
  const Params* p; int l; bool dry;
  DI void operator()(int rb, int cb, const f32x16& acc, int r, int h) const {
    const float* X = (const float*)(p->ws + OFF_X);
    float* Xo = (float*)(p->ws + (dry ? OFF_X2 : OFF_X));
    const int col = cb + r;
    const float g1 = ((const float*)(p->ws + OFF_MOD))[(size_t)(l * 3 + tok_grp(rb)) * 6144 + 2048 + col];
#pragma unroll
    for (int e = 0; e < 16; ++e) {
      size_t idx = (size_t)(rb + crow(e, h)) * DM + col;
      Xo[idx] = ALPHA * X[idx] + g1 * acc[e];
    }
  }
};
struct EpiG3 {
  const Params* p;
  DI void operator()(int rb, int cb, const f32x16& acc, int r, int h) const {
    bf16_t* Q = (bf16_t*)(p->ws + OFF_Q);
    const int col = cb + r;
#pragma unroll
    for (int e = 0; e < 16; ++e) Q[(size_t)(rb + crow(e, h)) * DM + col] = f2bf(acc[e]);
  }
};

#define XB_TMO      128
#define XB_XCNT(j)  (256  + 64 * (j))
#define XB_XSUB(j)  (1280 + 64 * (j))
#define XB_XGEN(j)  (2304 + 64 * (j))
#define XB_TOP      3328
#define XB_TOPGEN   3392
#define XCD_BAR_WORDS 3456
#define XB_SPIN_CAP (1u << 18)
#define LAS __attribute__((address_space(3)))
DI unsigned xb_ld(unsigned* p) { return __hip_atomic_load(p, __ATOMIC_RELAXED, __HIP_MEMORY_SCOPE_AGENT); }
DI unsigned xb_add(unsigned* p, unsigned v) { return __hip_atomic_fetch_add(p, v, __ATOMIC_RELAXED, __HIP_MEMORY_SCOPE_AGENT); }
DI unsigned xb_xcc_id() { return (unsigned)__builtin_amdgcn_s_getreg((3 << 11) | 20) & 0xFu; }
#define XB_SPIN(cond, bar) do { unsigned _sp = 0; while (cond) { __builtin_amdgcn_s_sleep(1); \
    if ((++_sp & 255u) == 0u) { if (xb_ld(&(bar)[XB_TMO])) break; if (_sp > XB_SPIN_CAP) { atomicAdd(&(bar)[XB_TMO], 1u); break; } } } } while (0)
struct XcdBarrier { unsigned* bar; unsigned x; volatile LAS unsigned* st; };
DI XcdBarrier xcd_barrier_post(unsigned* bar, volatile LAS unsigned* st) {
  XcdBarrier b; b.bar = bar; b.x = xb_xcc_id(); b.st = st;
  if (threadIdx.x == 0) (void)xb_add(&bar[XB_XCNT(b.x)], 1u);
  return b;
}
DI void xcd_barrier_complete(unsigned* bar, unsigned x, unsigned& nloc, unsigned& nx, unsigned G) {
  unsigned sum, cnt, mine, sp = 0u;
  for (;;) {
    sum = 0u; cnt = 0u; mine = 0u;
#pragma unroll
    for (unsigned j = 0; j < 16; ++j) { const unsigned c = xb_ld(&bar[XB_XCNT(j)]); sum += c; cnt += (c > 0u) ? 1u : 0u; mine = (j == x) ? c : mine; }
    if (sum == G) break;
    __builtin_amdgcn_s_sleep(1);
    if ((++sp & 255u) == 0u) { if (xb_ld(&bar[XB_TMO])) break; if (sp > XB_SPIN_CAP) { atomicAdd(&bar[XB_TMO], 1u); break; } }
  }
  nloc = mine > 0u ? mine : 1u; nx = cnt > 0u ? cnt : 1u;
}
DI void xcd_barrier(unsigned* bar_, volatile LAS unsigned* st_, unsigned G) {
  XcdBarrier b; b.bar = bar_; b.x = xb_xcc_id(); b.st = st_;
  asm volatile("s_waitcnt vmcnt(0)" ::: "memory");
  __syncthreads();
  if (threadIdx.x == 0) {
    unsigned* bar = b.bar;
    __builtin_amdgcn_s_waitcnt(0);
    unsigned nloc = b.st[0], nx = b.st[1];
    if (nloc == 0u) { xcd_barrier_complete(bar, b.x, nloc, nx, G); b.st[0] = nloc; b.st[1] = nx; }
    const unsigned old = xb_add(&bar[XB_XSUB(b.x)], 1u);
    const unsigned gen = old / nloc;
    if (old + 1u == (gen + 1u) * nloc) {
      __builtin_amdgcn_fence(__ATOMIC_RELEASE, "agent");
      asm volatile("s_waitcnt vmcnt(0)" ::: "memory");
      const unsigned og = xb_add(&bar[XB_TOP], 1u);
      const unsigned tg = og / nx;
      if (og + 1u == (tg + 1u) * nx) xb_add(&bar[XB_TOPGEN], 1u);
      else XB_SPIN(xb_ld(&bar[XB_TOPGEN]) == tg, bar);
      __builtin_amdgcn_fence(__ATOMIC_ACQUIRE, "agent");
      xb_add(&bar[XB_XGEN(b.x)], 1u);
      asm volatile("s_waitcnt vmcnt(0)" ::: "memory");
    } else {
      XB_SPIN(xb_ld(&bar[XB_XGEN(b.x)]) == gen, bar);
      __builtin_amdgcn_fence(__ATOMIC_ACQUIRE, "agent");
      asm volatile("s_waitcnt vmcnt(0)" ::: "memory");
    }
  }
  __syncthreads();
}

constexpr int SMEM_BYTES = 78848;
static_assert(SMEM_BYTES >= 4 * 1024 * 4, "peer smem");
static_assert(SMEM_BYTES >= 2 * 2 * 128 * GSTR * 2, "gemm smem");
static_assert(SMEM_BYTES >= (128 * KSTR + 64 * VSTR) * 2, "attn smem");

__global__ void __launch_bounds__(NTHR, 2) fwd_megakernel(Params p) {
  __shared__ __attribute__((aligned(16))) char smem[SMEM_BYTES];
  __shared__ uint4 xb_words, xg_words;
  cg::grid_group grid = cg::this_grid();
  if (threadIdx.x == 0) { xb_words = make_uint4(0u, 0u, 0u, 0u); xg_words = make_uint4(0u, 0u, 0u, 0u); }
  __syncthreads();
  const Grp gr = my_grp();
  unsigned* gbar = (unsigned*)(p.ws + OFF_BAR);
  unsigned* mbar = (unsigned*)(p.ws + OFF_BAR + (size_t)(1 + gr.g) * 16384);
  unsigned* flag = (unsigned*)(p.ws + OFF_BAR + 3 * 16384);
  (void)xcd_barrier_post(gbar, (volatile LAS unsigned*)&xb_words);
  (void)xcd_barrier_post(mbar, (volatile LAS unsigned*)&xg_words);
  if (p.ws == nullptr) grid.sync();
#define GBARRIER() xcd_barrier(gbar, (volatile LAS unsigned*)&xb_words, gridDim.x)
#define MBARRIER() xcd_barrier(mbar, (volatile LAS unsigned*)&xg_words, (unsigned)gr.GB)
  phase0(p, smem);
  GBARRIER();
  const int nshard = 8;
  phase_modreduce(p);
  GBARRIER();
  phase_ln0(p);
  GBARRIER();
  if (SPLIT_OFFSET && gr.g == 1) {
    convert_tables(p, 2 * NEXP, 4 * NEXP, gr.lb * 4 + (int)(threadIdx.x >> 6), gr.GB * 4);
    __threadfence();
    __syncthreads();
    if (threadIdx.x == 0) atomicAdd(flag, 1u);
  }
  int* ctr = (int*)(p.ws + OFF_QCTR) + gr.g * (32 * 512);
  for (int l = 0; l < DEPTH; ++l) {
    gemm_phase(gr, nshard, (const bf16_t*)(p.ws + OFF_H), (const bf16_t*)(p.ws + OFF_WINT) + (size_t)l * PC * DM, PC, smem, ctr + ((l * 4 + 0) * 2) * 512, EpiG1{&p, l});
    MBARRIER();
    phase_mixers(gr, nshard, p, l, smem, ctr + ((l * 4 + 1) * 2) * 512);
    MBARRIER();
    gemm_phase(gr, nshard, (const bf16_t*)(p.ws + OFF_O), (const bf16_t*)(p.ws + OFF_WOUTT) + (size_t)l * DM * DM, DM, smem, ctr + ((l * 4 + 2) * 2) * 512, EpiG2{&p, l, false});
    MBARRIER();
    phase_ln1(gr, p, l, false);
    MBARRIER();
    gemm_phase(gr, nshard, (const bf16_t*)(p.ws + OFF_H), (const bf16_t*)(p.ws + OFF_WQT) + (size_t)l * DM * DM, DM, smem, ctr + ((l * 4 + 3) * 2) * 512, EpiG3{&p});
    if (SPLIT_OFFSET && l == 2 && gr.g == 0) {
      if (threadIdx.x == 0) { XB_SPIN(xb_ld(flag) < (unsigned)gr.GB, gbar); }
      __syncthreads();
    }
    MBARRIER();
    phase_peer(gr, p, l, smem, false);
    if (l + 1 < DEPTH) MBARRIER();
  }
}

extern "C" void kernel_launch(void* const* d_in, const int* in_sizes, int n_in, void* d_out, int out_size, void* d_ws,
                              size_t ws_size, hipStream_t stream) {
  static int grid_blocks = 0;
  if (!grid_blocks) {
    int dev = 0, cus = 0, per_cu = 0;
    (void)hipGetDevice(&dev);
    (void)hipDeviceGetAttribute(&cus, hipDeviceAttributeMultiprocessorCount, dev);
    (void)hipOccupancyMaxActiveBlocksPerMultiprocessor(&per_cu, fwd_megakernel, NTHR, 0);
    if (per_cu > 2) per_cu = 2;
    if (per_cu < 1) per_cu = 1;
    grid_blocks = cus * per_cu;
  }
  Params p{};
  const float** pp = (const float**)&p;
  for (int i = 0; i < 26; ++i) pp[i] = (const float*)d_in[i];
  p.out = (float*)d_out;
  p.ws = (char*)d_ws;
  void* args[] = {&p};
  (void)hipMemsetAsync((char*)d_ws + OFF_BAR, 0, 4 * 16384, stream);
  hipError_t e = hipLaunchCooperativeKernel((void*)fwd_megakernel, dim3(grid_blocks), dim3(NTHR), args, 0, stream);
  if (e != hipSuccess) fprintf(stderr, "cooperative launch failed: %s (grid %d)\n", hipGetErrorString(e), grid_blocks);
}
```

```cpp
#include <hip/hip_runtime.h>
#include <hip/hip_cooperative_groups.h>
#include <cstdio>
namespace cg = cooperative_groups;

#define DI __device__ __forceinline__
typedef short bf16x8 __attribute__((ext_vector_type(8)));
typedef short s16x4 __attribute__((ext_vector_type(4)));
typedef float f32x16 __attribute__((ext_vector_type(16)));
typedef unsigned short bf16_t;
typedef unsigned u32x4 __attribute__((ext_vector_type(4)));
#define MFMA(a, b, c) __builtin_amdgcn_mfma_f32_32x32x16_bf16((a), (b), (c), 0, 0, 0)

constexpr int DM = 1024, TCTX = 4096, TLAT = 2048, NT = 6144, PC = 2048, DEPTH = 4;
constexpr int NEXP = 16384;
constexpr float ALPHA = 1.681792830507429f;
constexpr float LN_EPS = 1e-5f;
constexpr int NTHR = 256;

constexpr size_t OUT_Y = 0;
constexpr size_t OUT_WK = 6291456, OUT_WV = 8388608, OUT_DK = 10485760, OUT_DV = 14680064;

constexpr size_t SZ_WINT = (size_t)DEPTH * PC * DM * 2;
constexpr size_t SZ_WSQ = (size_t)DEPTH * DM * DM * 2;
constexpr size_t SZ_TAB = (size_t)DEPTH * NEXP * DM * 2;
constexpr size_t OFF_WINT = 0;
constexpr size_t OFF_WOUTT = OFF_WINT + SZ_WINT;
constexpr size_t OFF_WQT = OFF_WOUTT + SZ_WSQ;
constexpr size_t OFF_UB = OFF_WQT + SZ_WSQ;
constexpr size_t OFF_VB = OFF_UB + SZ_TAB;
constexpr size_t OFF_X = OFF_VB + SZ_TAB;
constexpr size_t OFF_H = OFF_X + (size_t)NT * DM * 4;
constexpr size_t OFF_P = OFF_H + (size_t)NT * DM * 2;
constexpr size_t OFF_O = OFF_P + (size_t)NT * PC * 2;
constexpr size_t OFF_Q = OFF_O + (size_t)NT * DM * 2;
constexpr size_t OFF_MOD = OFF_Q + (size_t)NT * DM * 4;
constexpr size_t OFF_MODP = OFF_MOD + (size_t)DEPTH * 3 * 6144 * 4;
constexpr size_t OFF_ROPEB = OFF_MODP + (size_t)DEPTH * 16 * 3 * 6144 * 4;
constexpr size_t OFF_ROPEC = OFF_ROPEB + (size_t)1024 * 64 * 2 * 4;
constexpr size_t OFF_LAM = OFF_ROPEC + (size_t)1024 * 32 * 2 * 4;
constexpr size_t OFF_CTR = OFF_LAM + 256;
constexpr size_t OFF_CWKB = OFF_CTR + 1024;
constexpr size_t OFF_CWVB = OFF_CWKB + (size_t)2 * 4 * 256 * 128 * 2;
constexpr size_t OFF_CDKB = OFF_CWVB + (size_t)2 * 4 * 256 * 128 * 2;
constexpr size_t OFF_CDVB = OFF_CDKB + (size_t)2 * 4 * 256 * 256 * 2;
constexpr size_t OFF_USC = OFF_CDVB + (size_t)2 * 4 * 256 * 256 * 2;
constexpr size_t OFF_VSC = OFF_USC + (size_t)DEPTH * NEXP * 4;
constexpr size_t OFF_KEYB = OFF_VSC + (size_t)DEPTH * NEXP * 4;
constexpr size_t OFF_BAR = OFF_KEYB + (size_t)DEPTH * 2 * 128 * 64 * 2; constexpr size_t OFF_BAR_UNUSED = OFF_CDVB + (size_t)2 * 4 * 256 * 256 * 2;
constexpr size_t OFF_X2 = OFF_BAR + 4 * 16384;
constexpr size_t OFF_H2 = OFF_X2 + (size_t)NT * DM * 4;
constexpr size_t OFF_QCTR = OFF_H2 + (size_t)NT * DM * 2;
constexpr int REP_P0 = 1, REP_G1 = 1, REP_MIX = 1, REP_G2 = 1, REP_LN1 = 1, REP_G3 = 1, REP_PEER = 1;
constexpr int SLOT_OFF = 78000;

struct Params {
  const float *x_prompt, *x_sample, *c, *cwk, *cwv, *cdk, *cdv, *c_ctx, *w_mod, *b_mod, *w_in, *w_out, *chunk_w, *chunk_b,
      *win_sink, *lam_q, *lam_k, *subln_g, *pool_w, *pool_scale, *ln_g, *ln_b, *peer_wq, *peer_keys, *peer_u, *peer_v;
  float* out;
  char* ws;
};

typedef __bf16 bf2v_t __attribute__((ext_vector_type(2)));
typedef float f2v_t __attribute__((ext_vector_type(2)));
DI unsigned pk2(float a, float b) { f2v_t v = {a, b}; return __builtin_bit_cast(unsigned, __builtin_convertvector(v, bf2v_t)); }
DI unsigned short f2bf(float x) { return (unsigned short)(pk2(x, 0.f) & 0xffffu); }
DI float bflo(unsigned u) { return __uint_as_float(u << 16); }
DI float bfhi(unsigned u) { return __uint_as_float(u & 0xffff0000u); }
DI float gelu_t(float x) { return x / (1.f + __expf(-1.5957691216057308f * (x + 0.044715f * x * x * x))); }
DI float wave_sum(float v) {
#pragma unroll
  for (int o = 32; o; o >>= 1) v += __shfl_xor(v, o);
  return v;
}
typedef __bf16 bf2_t __attribute__((ext_vector_type(2)));
DI float dot2bf(unsigned a, unsigned b, float c) { return __builtin_amdgcn_fdot2_f32_bf16(__builtin_bit_cast(bf2_t, a), __builtin_bit_cast(bf2_t, b), c, false); }
typedef float f32x4nt_t __attribute__((ext_vector_type(4)));
DI float4 ld_nt4(const float* p) { const f32x4nt_t t = __builtin_nontemporal_load((const f32x4nt_t*)p); return make_float4(t[0], t[1], t[2], t[3]); }
DI int opaque_tid() { int t = threadIdx.x; asm volatile("" : "+v"(t)); return t; }
struct Grp { int g, lb, GB, j, lq, QB; };
DI Grp my_grp() { Grp r; r.GB = (int)gridDim.x >> 1; r.g = (int)blockIdx.x & 1; r.lb = (int)blockIdx.x >> 1; r.j = r.lb & 3; r.lq = r.lb >> 2; r.QB = r.GB >> 2; return r; }
DI int mtile_g(int g, int mt) { return mt < 16 ? g * 16 + mt : 32 + g * 8 + (mt - 16); }
DI int tok_g(int g, int u) { return u < 2048 ? g * 2048 + u : TCTX + g * 1024 + (u - 2048); }
constexpr int GTOK = 3072;
constexpr int QTOK = 768;
constexpr bool SPLIT_OFFSET = true;
DI int next_tile_q(const Grp& gr, int* ctrq, char* smem, bool& first) {
  int* slot = (int*)(smem + SLOT_OFF);
  if (first) { first = false; return gr.lq; }
  __syncthreads();
  if (threadIdx.x == 0) *slot = gr.QB + atomicAdd(ctrq, 1);
  __syncthreads();
  return *slot;
}
DI int next_item(const Grp& gr, int* ctr, char* smem, bool& first, int nshard) {
  int* slot = (int*)(smem + SLOT_OFF);
  if (first) { first = false; return gr.lb; }
  __syncthreads();
  if (threadIdx.x == 0) {
    const int q = (nshard == 8) ? (gr.lb & 7) : 0;
    *slot = gr.GB + q + nshard * atomicAdd(ctr + q * 64, 1);
  }
  __syncthreads();
  return *slot;
}
DI int crow(int reg, int h) { return (reg & 3) + 8 * (reg >> 2) + 4 * h; }
DI uint4 pack8(const float* v) {
  uint4 r;
  r.x = pk2(v[0], v[1]); r.y = pk2(v[2], v[3]); r.z = pk2(v[4], v[5]); r.w = pk2(v[6], v[7]);
  return r;
}
DI bf16x8 as_bf16x8(uint4 u) { return __builtin_bit_cast(bf16x8, u); }

DI void load_row(const float* p, int lane, float (&v)[16]) {
#pragma unroll
  for (int c = 0; c < 2; ++c) {
    float4 a = *(const float4*)(p + c * 512 + lane * 8);
    float4 b = *(const float4*)(p + c * 512 + lane * 8 + 4);
    v[c * 8 + 0] = a.x; v[c * 8 + 1] = a.y; v[c * 8 + 2] = a.z; v[c * 8 + 3] = a.w;
    v[c * 8 + 4] = b.x; v[c * 8 + 5] = b.y; v[c * 8 + 6] = b.z; v[c * 8 + 7] = b.w;
  }
}
DI void store_row(float* p, int lane, const float (&v)[16]) {
#pragma unroll
  for (int c = 0; c < 2; ++c) {
    *(float4*)(p + c * 512 + lane * 8) = make_float4(v[c * 8 + 0], v[c * 8 + 1], v[c * 8 + 2], v[c * 8 + 3]);
    *(float4*)(p + c * 512 + lane * 8 + 4) = make_float4(v[c * 8 + 4], v[c * 8 + 5], v[c * 8 + 6], v[c * 8 + 7]);
  }
}
DI void store_row_bf(bf16_t* p, int lane, const float (&v)[16]) {
#pragma unroll
  for (int c = 0; c < 2; ++c) *(uint4*)(p + c * 512 + lane * 8) = pack8(&v[c * 8]);
}
DI void load_row16(const float* p, int lane, float (&v)[16]) {
#pragma unroll
  for (int j = 0; j < 4; ++j) {
    float4 a = *(const float4*)(p + j * 256 + lane * 4);
    v[4 * j] = a.x; v[4 * j + 1] = a.y; v[4 * j + 2] = a.z; v[4 * j + 3] = a.w;
  }
}
DI void store_row16(float* p, int lane, const float (&v)[16]) {
#pragma unroll
  for (int j = 0; j < 4; ++j) *(float4*)(p + j * 256 + lane * 4) = make_float4(v[4 * j], v[4 * j + 1], v[4 * j + 2], v[4 * j + 3]);
}
DI void ln_stats(const float (&v)[16], float& mu, float& rstd) {
  float s = 0.f;
#pragma unroll
  for (int i = 0; i < 16; ++i) s += v[i];
  s = wave_sum(s);
  mu = s * (1.f / 1024.f);
  float q = 0.f;
#pragma unroll
  for (int i = 0; i < 16; ++i) { float d = v[i] - mu; q += d * d; }
  q = wave_sum(q);
  rstd = rsqrtf(q * (1.f / 1024.f) + LN_EPS);
}
DI int tok_grp(int t) { return t < TCTX ? 0 : 1 + ((t - TCTX) >> 10); }
DI void ln_mod_to_bf(const float (&v)[16], const float* modv, int shoff, bf16_t* dst, int lane) {
  float mu, rstd;
  ln_stats(v, mu, rstd);
  float sh[16], sc[16], h[16];
  load_row(modv + shoff, lane, sh);
  load_row(modv + shoff + 1024, lane, sc);
#pragma unroll
  for (int i = 0; i < 16; ++i) h[i] = (v[i] - mu) * rstd * (1.f + sc[i]) + sh[i];
  store_row_bf(dst, lane, h);
}

DI void convert_tables(const Params& p, int r0, int r1, int gw, int nw) {
  char* ws = p.ws;
  const int lane = opaque_tid() & 63;
  const int nrow = r1 - r0;
  for (int bi = gw * 4; bi < 2 * nrow; bi += nw * 4) {
    const int tb = bi >= nrow ? 1 : 0;
    const int row = r0 + (bi - tb * nrow);
    const float* src = (tb ? p.peer_v : p.peer_u) + ((size_t)row << 10) + lane * 4;
    unsigned char* dst = (unsigned char*)(ws + OFF_UB) + ((size_t)row << 11) + tb * 1024 + lane * 16;
    float* sc = (float*)(ws + (tb ? OFF_VSC : OFF_USC)) + row;
    float4 x[4][4];
#pragma unroll
    for (int rr = 0; rr < 4; ++rr)
#pragma unroll
      for (int j = 0; j < 4; ++j) x[rr][j] = ld_nt4(src + (size_t)rr * 1024 + j * 256);
#pragma unroll
    for (int rr = 0; rr < 4; ++rr) {
      float am = 0.f;
#pragma unroll
      for (int j = 0; j < 4; ++j) am = fmaxf(am, fmaxf(fmaxf(fabsf(x[rr][j].x), fabsf(x[rr][j].y)), fmaxf(fabsf(x[rr][j].z), fabsf(x[rr][j].w))));
#pragma unroll
      for (int o = 32; o; o >>= 1) am = fmaxf(am, __shfl_xor(am, o));
      const float scale = am > 0.f ? 256.f / am : 1.f;
      u32x4 q;
#pragma unroll
      for (int j = 0; j < 4; ++j) {
        int w = __builtin_amdgcn_cvt_pk_fp8_f32(x[rr][j].x * scale, x[rr][j].y * scale, 0, false);
        w = __builtin_amdgcn_cvt_pk_fp8_f32(x[rr][j].z * scale, x[rr][j].w * scale, w, true);
        q[j] = (unsigned)w;
      }
      *(u32x4*)(dst + (size_t)rr * 2048) = q;
      if (lane == 0) sc[rr] = am > 0.f ? am * (1.f / 256.f) : 1.f;
    }
  }
}

DI void transpose_tile(const float* src, bf16_t* dst, int K, int N, int k0, int n0, float* tile  ) {
  const int tid = threadIdx.x;
#pragma unroll
  for (int i = 0; i < 4; ++i) {
    const int row = i * 16 + (tid >> 4), c4 = (tid & 15) * 4;
    const float4 v = ld_nt4(src + (size_t)(k0 + row) * N + n0 + c4);
    tile[row * 65 + c4] = v.x; tile[row * 65 + c4 + 1] = v.y; tile[row * 65 + c4 + 2] = v.z; tile[row * 65 + c4 + 3] = v.w;
  }
  __syncthreads();
#pragma unroll
  for (int i = 0; i < 2; ++i) {
    const int nrow = i * 32 + (tid >> 3), kc = (tid & 7) * 8;
    float f[8];
#pragma unroll
    for (int k = 0; k < 8; ++k) f[k] = tile[(kc + k) * 65 + nrow];
    *(uint4*)(dst + (size_t)(n0 + nrow) * K + k0 + kc) = pack8(f);
  }
  __syncthreads();
}

DI void phase0(const Params& p, char* smem) {
  const int tid = threadIdx.x;
  const int gthreads = gridDim.x * NTHR;
  const int gtid = blockIdx.x * NTHR + tid;
  char* ws = p.ws;
  for (int it = blockIdx.x; it < DEPTH * 1024; it += gridDim.x) {
    int l = it >> 10, r = it & 1023;
    if (r < 512) {
      int kt = r >> 5, nt = r & 31;
      transpose_tile(p.w_in + (size_t)l * DM * PC, (bf16_t*)(ws + OFF_WINT) + (size_t)l * PC * DM, DM, PC, kt * 64, nt * 64, (float*)smem);
    } else if (r < 768) {
      int q = r - 512, kt = q >> 4, nt = q & 15;
      transpose_tile(p.w_out + (size_t)l * DM * DM, (bf16_t*)(ws + OFF_WOUTT) + (size_t)l * DM * DM, DM, DM, kt * 64, nt * 64, (float*)smem);
    } else {
      int q = r - 768, kt = q >> 4, nt = q & 15;
      transpose_tile(p.peer_wq + (size_t)l * DM * DM, (bf16_t*)(ws + OFF_WQT) + (size_t)l * DM * DM, DM, DM, kt * 64, nt * 64, (float*)smem);
    }
  }
  {
    float* sv = (float*)smem;
    float* red = sv + 3 * 1024;
    for (int i = tid; i < 3 * 1024; i += NTHR) {
      int v = i >> 10, k = i & 1023;
      float x = (v == 0) ? p.c_ctx[k] : p.c[(v - 1) * 1024 + k];
      sv[i] = x / (1.f + __expf(-x));
    }
    __syncthreads();
    const int wave = tid >> 6, lane = tid & 63;
    float* modp = (float*)(ws + OFF_MODP);
    for (int it = blockIdx.x; it < DEPTH * 24 * 16; it += gridDim.x) {
      int l = it / 384, r = it % 384, nb = r >> 4, ks = r & 15;
      int kbase = ks * 64 + wave * 16;
      const float* wp = p.w_mod + ((size_t)l * DM + kbase) * 6144 + nb * 256 + lane * 4;
      float4 w[16];
#pragma unroll
      for (int k = 0; k < 16; ++k) w[k] = ld_nt4(wp + (size_t)k * 6144);
      float a[3][4];
#pragma unroll
      for (int v = 0; v < 3; ++v) { a[v][0] = a[v][1] = a[v][2] = a[v][3] = 0.f; }
#pragma unroll
      for (int k = 0; k < 16; ++k) {
#pragma unroll
        for (int v = 0; v < 3; ++v) {
          float s = sv[v * 1024 + kbase + k];
          a[v][0] += s * w[k].x; a[v][1] += s * w[k].y; a[v][2] += s * w[k].z; a[v][3] += s * w[k].w;
        }
      }
#pragma unroll
      for (int v = 0; v < 3; ++v)
        *(float4*)&red[(wave * 3 + v) * 256 + lane * 4] = make_float4(a[v][0], a[v][1], a[v][2], a[v][3]);
      __syncthreads();
      for (int i = tid; i < 768; i += NTHR) {
        int v = i >> 8, cidx = i & 255;
        float s = red[(0 * 3 + v) * 256 + cidx] + red[(1 * 3 + v) * 256 + cidx] + red[(2 * 3 + v) * 256 + cidx] + red[(3 * 3 + v) * 256 + cidx];
        modp[(((size_t)l * 16 + ks) * 3 + v) * 6144 + nb * 256 + cidx] = s;
      }
      __syncthreads();
    }
  }
  convert_tables(p, 0, (SPLIT_OFFSET ? 2 : 4) * NEXP, blockIdx.x * 4 + (tid >> 6), gridDim.x * 4);
  {
    const int n1 = 2 * 4 * 256 * 128 / 8, n2 = 2 * 4 * 256 * 256 / 8;
    for (int i = gtid; i < 2 * n1 + 2 * n2; i += gthreads) {
      const float* src; uint4* dst; int j;
      if (i < n1) { src = p.cwk; dst = (uint4*)(ws + OFF_CWKB); j = i; }
      else if (i < 2 * n1) { src = p.cwv; dst = (uint4*)(ws + OFF_CWVB); j = i - n1; }
      else if (i < 2 * n1 + n2) { src = p.cdk; dst = (uint4*)(ws + OFF_CDKB); j = i - 2 * n1; }
      else { src = p.cdv; dst = (uint4*)(ws + OFF_CDVB); j = i - 2 * n1 - n2; }
      float4 a = ((const float4*)src)[2 * j], bb = ((const float4*)src)[2 * j + 1];
      uint4 rr; rr.x = pk2(a.x, a.y); rr.y = pk2(a.z, a.w); rr.z = pk2(bb.x, bb.y); rr.w = pk2(bb.z, bb.w);
      dst[j] = rr;
    }
  }
  for (int i = gtid; i < DEPTH * 2 * 128 * 64 / 8; i += gthreads) {
    float4 a = ((const float4*)p.peer_keys)[2 * i], bb = ((const float4*)p.peer_keys)[2 * i + 1];
    uint4 rr; rr.x = pk2(a.x, a.y); rr.y = pk2(a.z, a.w); rr.z = pk2(bb.x, bb.y); rr.w = pk2(bb.z, bb.w);
    ((uint4*)(ws + OFF_KEYB))[i] = rr;
  }
  {
    float* rb = (float*)(ws + OFF_ROPEB);
    float* rc = (float*)(ws + OFF_ROPEC);
    for (int i = gtid; i < 1024 * 64; i += gthreads) {
      int pos = i >> 6, d = i & 63;
      float pv = (d < 32) ? (float)(pos >> 6) : (float)(pos & 63);
      float inv = powf(10000.f, -(float)(d & 15) / 16.f);
      float ang = pv * inv;
      rb[i] = cosf(ang);
      rb[1024 * 64 + i] = sinf(ang);
    }
    for (int i = gtid; i < 1024 * 32; i += gthreads) {
      int pos = i >> 5, d = i & 31;
      float pv = (d < 16) ? (float)(pos >> 6) : (float)(pos & 63);
      float inv = powf(10000.f, -(float)(d & 7) / 8.f);
      float ang = pv * inv;
      rc[i] = cosf(ang);
      rc[1024 * 32 + i] = sinf(ang);
    }
  }
  if (blockIdx.x == 0) { for (int i = tid; i < 2 * 32 * 512; i += NTHR) ((int*)(ws + OFF_QCTR))[i] = 0; }
  if (blockIdx.x == 0 && tid < DEPTH) {
    int l = tid;
    float s0 = 0.f, s1 = 0.f;
    for (int i = 0; i < 32; ++i) {
      s0 += p.lam_q[l * 64 + i] * p.lam_k[l * 64 + i];
      s1 += p.lam_q[l * 64 + 32 + i] * p.lam_k[l * 64 + 32 + i];
    }
    float lam_init = 0.8f - 0.6f * expf(-0.3f * (float)l);
    ((float*)(ws + OFF_LAM))[l] = expf(s0) - expf(s1) + lam_init;
    ((float*)(ws + OFF_LAM))[4 + l] = lam_init;
  }
}

DI void phase_modreduce(const Params& p) {
  const int gthreads = gridDim.x * NTHR;
  const int gtid = blockIdx.x * NTHR + threadIdx.x;
  const float* modp = (const float*)(p.ws + OFF_MODP);
  float* mod = (float*)(p.ws + OFF_MOD);
  for (int i = gtid; i < DEPTH * 3 * 6144; i += gthreads) {
    int l = i / (3 * 6144), r = i % (3 * 6144), n = r % 6144;
    float s = p.b_mod[l * 6144 + n];
#pragma unroll
    for (int ks = 0; ks < 16; ++ks) s += modp[((size_t)l * 16 + ks) * 3 * 6144 + r];
    mod[i] = s;
  }
}

DI void phase_ln0(const Params& p) {
  const int lane = threadIdx.x & 63;
  const int gw = blockIdx.x * 4 + (threadIdx.x >> 6), nw = gridDim.x * 4;
  float* X = (float*)(p.ws + OFF_X);
  bf16_t* H = (bf16_t*)(p.ws + OFF_H);
  const float* mod = (const float*)(p.ws + OFF_MOD);
  for (int t = gw; t < NT; t += nw) {
    const float* src = t < TCTX ? p.x_prompt + (size_t)t * DM : p.x_sample + (size_t)(t - TCTX) * DM;
    float v[16];
#pragma unroll
    for (int c = 0; c < 2; ++c) {
      const float4 a = ld_nt4(src + c * 512 + lane * 8), bq = ld_nt4(src + c * 512 + lane * 8 + 4);
      v[c * 8 + 0] = a.x; v[c * 8 + 1] = a.y; v[c * 8 + 2] = a.z; v[c * 8 + 3] = a.w;
      v[c * 8 + 4] = bq.x; v[c * 8 + 5] = bq.y; v[c * 8 + 6] = bq.z; v[c * 8 + 7] = bq.w;
    }
    store_row(X + (size_t)t * DM, lane, v);
    ln_mod_to_bf(v, mod + (size_t)(0 * 3 + tok_grp(t)) * 6144, 0, H + (size_t)t * DM, lane);
  }
}

DI void phase_ln1(const Grp& gr, const Params& p, int l, bool dry) {
  const int tid = opaque_tid();
  const int lane = tid & 63;
  const int gw = gr.lq * 4 + (tid >> 6), nw = gr.QB * 4;
  const float* X = (const float*)(p.ws + OFF_X);
  float* Xo = (float*)(p.ws + (dry ? OFF_X2 : OFF_X));
  bf16_t* H = (bf16_t*)(p.ws + (dry ? OFF_H2 : OFF_H));
  const float* mod = (const float*)(p.ws + OFF_MOD);
  for (int uq = gw; uq < QTOK; uq += nw) {
    const int t = tok_g(gr.g, gr.j * QTOK + uq);
    float v[16], g[16], b[16];
    load_row(X + (size_t)t * DM, lane, v);
    load_row(p.ln_g + (size_t)(l * 2 + 0) * DM, lane, g);
    load_row(p.ln_b + (size_t)(l * 2 + 0) * DM, lane, b);
    float mu, rstd;
    ln_stats(v, mu, rstd);
#pragma unroll
    for (int i = 0; i < 16; ++i) v[i] = (v[i] - mu) * rstd * g[i] + b[i];
    store_row(Xo + (size_t)t * DM, lane, v);
    ln_mod_to_bf(v, mod + (size_t)(l * 3 + tok_grp(t)) * 6144, 3072, H + (size_t)t * DM, lane);
  }
}

constexpr int GSTR = 72;
template <class Epi>
DI void gemm_phase(const Grp& gr, int nshard, const bf16_t* __restrict__ A, const bf16_t* __restrict__ Bt, int N, char* smem, int* ctr, Epi epi) {
  const int tid = opaque_tid(), lane = tid & 63, wave = tid >> 6;
  const int r = lane & 31, h = lane >> 5;
  const int wm = wave >> 1, wn = wave & 1;
  bf16_t* As = (bf16_t*)smem;
  bf16_t* Bs = As + 2 * 128 * GSTR;
  const int tiles_n = N >> 7;
  const int ntiles = 6 * tiles_n;
  bool qfirst = true;
  for (;;) {
    const int tile = next_tile_q(gr, ctr + gr.j * 64, smem, qfirst);
    if (tile >= ntiles) break;
    const int tn = tile % tiles_n, tm = mtile_g(gr.g, gr.j * 6 + tile / tiles_n);
    const int m0 = tm * 128, n0 = tn * 128;
    const bf16_t* Ap = A + (size_t)m0 * DM;
    const bf16_t* Bp = Bt + (size_t)n0 * DM;
    f32x16 acc[2][2];
#pragma unroll
    for (int i = 0; i < 2; ++i)
#pragma unroll
      for (int j = 0; j < 2; ++j)
#pragma unroll
        for (int e = 0; e < 16; ++e) acc[i][j][e] = 0.f;
    u32x4 ra0[4], rb0[4], ra1[4], rb1[4];
    const bf16_t* Ag = Ap + (size_t)(tid >> 3) * DM + (tid & 7) * 8;
    const bf16_t* Bg = Bp + (size_t)(tid >> 3) * DM + (tid & 7) * 8;
    const int lofs = (tid >> 3) * GSTR + (tid & 7) * 8;
#define G_LOAD(RA, RB, KT) { _Pragma("unroll") for (int i = 0; i < 4; ++i) { \
      RA[i] = *(const u32x4*)(Ag + (size_t)i * 32 * DM + (KT) * 64); RB[i] = *(const u32x4*)(Bg + (size_t)i * 32 * DM + (KT) * 64); } }
#define G_STORE(RA, RB, BUF) { _Pragma("unroll") for (int i = 0; i < 4; ++i) { \
      *(u32x4*)(As + (BUF) * 128 * GSTR + lofs + i * 32 * GSTR) = RA[i]; *(u32x4*)(Bs + (BUF) * 128 * GSTR + lofs + i * 32 * GSTR) = RB[i]; } }
#define G_FRAGS(SET, Ac, Bc, KS) { \
        fa0[SET] = *(const bf16x8*)(Ac + (wm * 64 + r) * GSTR + (KS) * 16 + h * 8); \
        fa1[SET] = *(const bf16x8*)(Ac + (wm * 64 + 32 + r) * GSTR + (KS) * 16 + h * 8); \
        fb0[SET] = *(const bf16x8*)(Bc + (wn * 64 + r) * GSTR + (KS) * 16 + h * 8); \
        fb1[SET] = *(const bf16x8*)(Bc + (wn * 64 + 32 + r) * GSTR + (KS) * 16 + h * 8); }
#define G_MFMAS(SET) { \
        acc[0][0] = MFMA(fa0[SET], fb0[SET], acc[0][0]); acc[0][1] = MFMA(fa0[SET], fb1[SET], acc[0][1]); \
        acc[1][0] = MFMA(fa1[SET], fb0[SET], acc[1][0]); acc[1][1] = MFMA(fa1[SET], fb1[SET], acc[1][1]); }
#define G_COMPUTE(BUF) { const bf16_t* Ac = As + (BUF) * 128 * GSTR; const bf16_t* Bc = Bs + (BUF) * 128 * GSTR; \
      bf16x8 fa0[2], fa1[2], fb0[2], fb1[2]; \
      G_FRAGS(0, Ac, Bc, 0); \
      __builtin_amdgcn_sched_barrier(0); \
      G_FRAGS(1, Ac, Bc, 1); \
      __builtin_amdgcn_sched_barrier(0); \
      G_MFMAS(0); \
      __builtin_amdgcn_sched_barrier(0); \
      G_FRAGS(0, Ac, Bc, 2); \
      __builtin_amdgcn_sched_barrier(0); \
      G_MFMAS(1); \
      __builtin_amdgcn_sched_barrier(0); \
      G_FRAGS(1, Ac, Bc, 3); \
      __builtin_amdgcn_sched_barrier(0); \
      G_MFMAS(0); \
      __builtin_amdgcn_sched_barrier(0); \
      G_MFMAS(1); \
      __builtin_amdgcn_sched_barrier(0); }
    G_LOAD(ra0, rb0, 0);
    G_LOAD(ra1, rb1, 1);
    G_STORE(ra0, rb0, 0);
    __syncthreads();
#pragma unroll 1
    for (int kt = 0; kt < 16; kt += 2) {
      if (kt + 2 < 16) G_LOAD(ra0, rb0, kt + 2);
      G_COMPUTE(0);
      G_STORE(ra1, rb1, 1);
      __syncthreads();
      if (kt + 3 < 16) G_LOAD(ra1, rb1, kt + 3);
      G_COMPUTE(1);
      if (kt + 2 < 16) G_STORE(ra0, rb0, 0);
      __syncthreads();
    }
#undef G_LOAD
#undef G_STORE
#undef G_COMPUTE
#undef G_FRAGS
#undef G_MFMAS
#pragma unroll
    for (int i = 0; i < 2; ++i)
#pragma unroll
      for (int j = 0; j < 2; ++j) epi(m0 + wm * 64 + i * 32, n0 + wn * 64 + j * 32, acc[i][j], r, h);
  }
}

constexpr int KSTR = 72;
constexpr int VSTR = 136;

struct AttnState { f32x16 o[2]; float m, l; };

DI void stage_k_bf(bf16_t* Ks, const bf16_t* src) {
  int tid = threadIdx.x;
  asm volatile("" : "+v"(tid));
#pragma unroll
  for (int i = 0; i < 4; ++i) {
    int id = tid + 256 * i, row = id >> 3, ch = id & 7;
    *(uint4*)(Ks + row * KSTR + ch * 8) = *(const uint4*)(src + (size_t)row * PC + ch * 8);
  }
}
DI void stage_k_f32(bf16_t* Ks, const float* src, int rstride) {
  int tid = threadIdx.x;
  asm volatile("" : "+v"(tid));
#pragma unroll
  for (int i = 0; i < 4; ++i) {
    int id = tid + 256 * i, row = id >> 3, ch = id & 7;
    const float* s = src + (size_t)row * rstride + ch * 8;
    float4 a = *(const float4*)s, b = *(const float4*)(s + 4);
    uint4 r; r.x = pk2(a.x, a.y); r.y = pk2(a.z, a.w); r.z = pk2(b.x, b.y); r.w = pk2(b.z, b.w);
    *(uint4*)(Ks + row * KSTR + ch * 8) = r;
  }
}
DI void stage_vt_bf(bf16_t* Vt, const bf16_t* src) {
  int tid = threadIdx.x;
  asm volatile("" : "+v"(tid));
#pragma unroll
  for (int i = 0; i < 4; ++i) {
    int id = tid + 256 * i, row = id & 127, ch = id >> 7;
    uint4 v = *(const uint4*)(src + (size_t)row * PC + ch * 8);
    unsigned w[4] = {v.x, v.y, v.z, v.w};
#pragma unroll
    for (int k = 0; k < 4; ++k) {
      Vt[(ch * 8 + 2 * k) * VSTR + row] = (bf16_t)(w[k] & 0xffffu);
      Vt[(ch * 8 + 2 * k + 1) * VSTR + row] = (bf16_t)(w[k] >> 16);
    }
  }
}
DI void stage_vt_f32(bf16_t* Vt, const float* src, int rstride) {
  int tid = threadIdx.x;
  asm volatile("" : "+v"(tid));
#pragma unroll
  for (int i = 0; i < 4; ++i) {
    int id = tid + 256 * i, row = id & 127, ch = id >> 7;
    const float* s = src + (size_t)row * rstride + ch * 8;
    float4 a = *(const float4*)s, b = *(const float4*)(s + 4);
    float f[8] = {a.x, a.y, a.z, a.w, b.x, b.y, b.z, b.w};
#pragma unroll
    for (int k = 0; k < 8; ++k) Vt[(ch * 8 + k) * VSTR + row] = f2bf(f[k]);
  }
}

template <int NKS>
DI void attn_tile(const bf16_t* Ks, int kcol0, const bf16_t* Vt, const bf16x8 (&qf)[NKS], AttnState& st, float cscale,
                  int maskmode, int qpos, int kpos0, int r, int h) {
  f32x16 s[2];
#pragma unroll
  for (int kb = 0; kb < 2; ++kb) {
#pragma unroll
    for (int e = 0; e < 16; ++e) s[kb][e] = 0.f;
#pragma unroll
    for (int ks = 0; ks < NKS; ++ks) {
      bf16x8 a = *(const bf16x8*)(Ks + (kb * 32 + r) * KSTR + kcol0 + ks * 16 + h * 8);
      s[kb] = MFMA(a, qf[ks], s[kb]);
    }
  }
  float tmax = -INFINITY;
#pragma unroll
  for (int kb = 0; kb < 2; ++kb)
#pragma unroll
    for (int e = 0; e < 16; ++e) {
      float v = s[kb][e] * cscale;
      if (maskmode) {
        int kp = kpos0 + kb * 32 + crow(e, h);
        int dd = kp - qpos; dd = dd < 0 ? -dd : dd;
        v = (dd <= 128) ? v : -INFINITY;
      }
      s[kb][e] = v;
      tmax = fmaxf(tmax, v);
    }
  tmax = fmaxf(tmax, __shfl_xor(tmax, 32));
  float mnew = fmaxf(st.m, tmax);
  float alpha = (mnew == -INFINITY) ? 1.f : __builtin_amdgcn_exp2f(st.m - mnew);
  float msub = (mnew == -INFINITY) ? 0.f : mnew;
  float psum = 0.f;
#pragma unroll
  for (int kb = 0; kb < 2; ++kb)
#pragma unroll
    for (int e = 0; e < 16; ++e) {
      float pv = __builtin_amdgcn_exp2f(s[kb][e] - msub);
      s[kb][e] = pv;
      psum += pv;
    }
  st.l = st.l * alpha + psum;
  st.m = mnew;
#pragma unroll
  for (int db = 0; db < 2; ++db)
#pragma unroll
    for (int e = 0; e < 16; ++e) st.o[db][e] *= alpha;
#pragma unroll
  for (int kb = 0; kb < 2; ++kb)
#pragma unroll
    for (int ss = 0; ss < 2; ++ss) {
      uint4 pu;
      pu.x = pk2(s[kb][8 * ss + 0], s[kb][8 * ss + 1]);
      pu.y = pk2(s[kb][8 * ss + 2], s[kb][8 * ss + 3]);
      pu.z = pk2(s[kb][8 * ss + 4], s[kb][8 * ss + 5]);
      pu.w = pk2(s[kb][8 * ss + 6], s[kb][8 * ss + 7]);
      bf16x8 pb = as_bf16x8(pu);
#pragma unroll
      for (int db = 0; db < 2; ++db) {
        const bf16_t* vp = Vt + (db * 32 + r) * VSTR + kb * 32 + 16 * ss + 4 * h;
        s16x4 lo = *(const s16x4*)vp;
        s16x4 hi = *(const s16x4*)(vp + 8);
        bf16x8 va = __builtin_shufflevector(lo, hi, 0, 1, 2, 3, 4, 5, 6, 7);
        st.o[db] = MFMA(va, pb, st.o[db]);
      }
    }
}

DI void store_oT(bf16_t* O, int token, int colbase, const f32x16 (&o)[2], int h) {
#pragma unroll
  for (int db = 0; db < 2; ++db)
#pragma unroll
    for (int g = 0; g < 4; ++g) {
      uint2 u;
      u.x = pk2(o[db][4 * g + 0], o[db][4 * g + 1]);
      u.y = pk2(o[db][4 * g + 2], o[db][4 * g + 3]);
      *(uint2*)(O + (size_t)token * DM + colbase + db * 32 + 8 * g + 4 * h) = u;
    }
}

DI void attn_init(AttnState& st, float m0, float l0) {
#pragma unroll
  for (int db = 0; db < 2; ++db)
#pragma unroll
    for (int e = 0; e < 16; ++e) st.o[db][e] = 0.f;
  st.m = m0;
  st.l = l0;
}

DI void mixer_bc(const Params& p, int l, bool isC, bool lat, int b, int hd, int qb, char* smem) {
  const int tid = opaque_tid(), lane = tid & 63, wave = tid >> 6, r = lane & 31, h = lane >> 5;
  const int qblk = wave >> 1, role = wave & 1;
  const int hdw = isC ? hd : (hd & ~1) + role;
  bf16_t* Ks = (bf16_t*)smem;
  bf16_t* Vt = Ks + 128 * KSTR;
  float* xch = (float*)smem;
  const bf16_t* P = (const bf16_t*)(p.ws + OFF_P);
  const int kv = hd >> 1;
  const int seq0 = lat ? TCTX + b * 1024 : b * 256;
  const int qpos = qb * 64 + qblk * 32 + r;
  const int qtok = seq0 + qpos;
  const float LOG2E = 1.4426950408889634f;
  bf16x8 qf[4];
  {
    const int qcol = isC ? 1024 + hd * 64 + role * 32 : 512 + hdw * 64;
    const bf16_t* qp = P + (size_t)qtok * PC + qcol + h * 8;
    qf[0] = *(const bf16x8*)(qp);
    qf[1] = *(const bf16x8*)(qp + 16);
    qf[2] = qf[0]; qf[3] = qf[1];
    if (!isC) { qf[2] = *(const bf16x8*)(qp + 32); qf[3] = *(const bf16x8*)(qp + 48); }
  }
  const float cscale = isC ? 0.17677669529663687f * LOG2E : 0.125f * LOG2E;
  AttnState st;
  if (isC) attn_init(st, -INFINITY, 0.f);
  else attn_init(st, p.win_sink[l * 4 + hdw] * LOG2E, (h == 0) ? 1.f : 0.f);
  const int ntile = isC ? (lat ? 10 : 2) : (lat ? 5 : 2);
  const int band0 = (qb >> 1) - 1;
  u32x4 kreg[4], vreg[4];
  auto tile_exists = [&](int ti) -> bool {
    if (!isC && lat && ti < 3) { int kt = band0 + ti; return kt >= 0 && kt < 8; }
    return true;
  };
  auto tile_load = [&](int ti) {
    const bf16_t *kp, *vp; int stride;
    if (isC) {
      if (lat && ti < 2) {
        const size_t off = ((size_t)(b * DEPTH + l) * 256 + ti * 128) * 256 + hd * 64;
        kp = (const bf16_t*)(p.ws + OFF_CDKB) + off; vp = (const bf16_t*)(p.ws + OFF_CDVB) + off; stride = 256;
      } else {
        const int kt = lat ? ti - 2 : ti;
        const bf16_t* base = P + (size_t)(seq0 + kt * 128) * PC;
        kp = base + 1280 + hd * 64; vp = base + 1536 + hd * 64; stride = PC;
      }
    } else {
      if (lat && ti >= 3) {
        const size_t off = ((size_t)(b * DEPTH + l) * 256 + (ti - 3) * 128) * 128 + kv * 64;
        kp = (const bf16_t*)(p.ws + OFF_CWKB) + off; vp = (const bf16_t*)(p.ws + OFF_CWVB) + off; stride = 128;
      } else {
        const int kt = lat ? band0 + ti : ti;
        const bf16_t* base = P + (size_t)(seq0 + kt * 128) * PC;
        kp = base + 768 + kv * 64; vp = base + 896 + kv * 64; stride = PC;
      }
    }
    int t2 = tid;
    asm volatile("" : "+v"(t2));
#pragma unroll
    for (int i = 0; i < 4; ++i) {
      int id = t2 + 256 * i;
      kreg[i] = *(const u32x4*)(kp + (size_t)(id >> 3) * stride + (id & 7) * 8);
      vreg[i] = *(const u32x4*)(vp + (size_t)(id & 127) * stride + (id >> 7) * 8);
    }
  };
  auto tile_store = [&]() {
    int t2 = tid;
    asm volatile("" : "+v"(t2));
#pragma unroll
    for (int i = 0; i < 4; ++i) {
      int id = t2 + 256 * i;
      *(u32x4*)(Ks + (id >> 3) * KSTR + (id & 7) * 8) = kreg[i];
      const int row = id & 127, ch = id >> 7;
#pragma unroll
      for (int k = 0; k < 4; ++k) {
        Vt[(ch * 8 + 2 * k) * VSTR + row] = (bf16_t)(vreg[i][k] & 0xffffu);
        Vt[(ch * 8 + 2 * k + 1) * VSTR + row] = (bf16_t)(vreg[i][k] >> 16);
      }
    }
  };
  if (tile_exists(0)) tile_load(0);
#pragma unroll 1
  for (int ti = 0; ti < ntile; ++ti) {
    const bool ex = tile_exists(ti);
    __syncthreads();
    if (ex) tile_store();
    __syncthreads();
    if (ti + 1 < ntile && tile_exists(ti + 1)) tile_load(ti + 1);
    if (ex) {
      if (isC) {
        const bf16x8 q2[2] = {qf[0], qf[1]};
#pragma unroll 1
        for (int hf = 0; hf < 2; ++hf)
          attn_tile<2>(Ks + hf * 64 * KSTR, role * 32, Vt + hf * 64, q2, st, cscale, 0, 0, 0, r, h);
      } else {
        const bool band = lat && ti < 3;
#pragma unroll 1
        for (int hf = 0; hf < 2; ++hf)
          attn_tile<4>(Ks + hf * 64 * KSTR, 0, Vt + hf * 64, qf, st, cscale, band ? 1 : 0, qpos, (band0 + ti) * 128 + hf * 64, r, h);
      }
    }
  }
  if (!isC) {
    const float inv = 1.f / (st.l + __shfl_xor(st.l, 32));
#pragma unroll
    for (int db = 0; db < 2; ++db)
#pragma unroll
      for (int e = 0; e < 16; ++e) st.o[db][e] *= inv;
    store_oT((bf16_t*)(p.ws + OFF_O), qtok, 256 + hdw * 64, st.o, h);
    return;
  }
  __syncthreads();
  float* xp = xch + (size_t)(qblk * 64 + lane) * 36;
  if (role == 1) {
#pragma unroll
    for (int db = 0; db < 2; ++db)
#pragma unroll
      for (int g = 0; g < 4; ++g)
        *(float4*)(xp + db * 16 + g * 4) = make_float4(st.o[db][4 * g], st.o[db][4 * g + 1], st.o[db][4 * g + 2], st.o[db][4 * g + 3]);
    xp[32] = st.m; xp[33] = st.l;
  }
  __syncthreads();
  if (role == 0) {
    f32x16 o1[2];
#pragma unroll
    for (int db = 0; db < 2; ++db)
#pragma unroll
      for (int g = 0; g < 4; ++g) {
        float4 v = *(const float4*)(xp + db * 16 + g * 4);
        o1[db][4 * g] = v.x; o1[db][4 * g + 1] = v.y; o1[db][4 * g + 2] = v.z; o1[db][4 * g + 3] = v.w;
      }
    const float m1 = xp[32], l1 = xp[33];
    if (isC) {
      const float lam = ((const float*)(p.ws + OFF_LAM))[l];
      const float lam_init = ((const float*)(p.ws + OFF_LAM))[4 + l];
      float i0 = 1.f / (st.l + __shfl_xor(st.l, 32));
      float i1 = lam / (l1 + __shfl_xor(l1, 32));
      float ss = 0.f;
#pragma unroll
      for (int db = 0; db < 2; ++db)
#pragma unroll
        for (int e = 0; e < 16; ++e) {
          float w = st.o[db][e] * i0 - o1[db][e] * i1;
          st.o[db][e] = w;
          ss += w * w;
        }
      ss += __shfl_xor(ss, 32);
      float rs = rsqrtf(ss * (1.f / 64.f) + LN_EPS) * (1.f - lam_init);
#pragma unroll
      for (int db = 0; db < 2; ++db)
#pragma unroll
        for (int e = 0; e < 16; ++e) st.o[db][e] *= rs * p.subln_g[l * 64 + db * 32 + crow(e, h)];
      store_oT((bf16_t*)(p.ws + OFF_O), qtok, 512 + hd * 64, st.o, h);
    } else {
      const float m = fmaxf(st.m, m1);
      const float a0 = __builtin_amdgcn_exp2f(st.m - m), a1 = __builtin_amdgcn_exp2f(m1 - m);
      float lt = st.l * a0 + l1 * a1;
      lt += __shfl_xor(lt, 32);
      const float inv = 1.f / lt;
      const float c0 = a0 * inv, c1 = a1 * inv;
#pragma unroll
      for (int db = 0; db < 2; ++db)
#pragma unroll
        for (int e = 0; e < 16; ++e) st.o[db][e] = st.o[db][e] * c0 + o1[db][e] * c1;
      store_oT((bf16_t*)(p.ws + OFF_O), qtok, 256 + hd * 64, st.o, h);
    }
  }
}

DI void mixer_a(const Params& p, int l, int ch, int hd, char* smem) {
  const int tid = opaque_tid(), lane = tid & 63, wave = tid >> 6, r = lane & 31, h = lane >> 5;
  bf16_t* Vt = (bf16_t*)smem;
  const bf16_t* P = (const bf16_t*)(p.ws + OFF_P);
  const int tok0 = ch * 128;
  __syncthreads();
  stage_vt_bf(Vt, P + (size_t)tok0 * PC + 256 + hd * 64);
  __syncthreads();
  const int pp = wave * 32 + r;
  const float* wrow = p.chunk_w + ((size_t)(l * 4 + hd) * 128 + pp) * 128;
  f32x16 acc[2];
#pragma unroll
  for (int db = 0; db < 2; ++db)
#pragma unroll
    for (int e = 0; e < 16; ++e) acc[db][e] = 0.f;
#pragma unroll
  for (int ks = 0; ks < 8; ++ks) {
    float4 a = *(const float4*)(wrow + ks * 16 + 8 * h), b = *(const float4*)(wrow + ks * 16 + 8 * h + 4);
    uint4 wu; wu.x = pk2(a.x, a.y); wu.y = pk2(a.z, a.w); wu.z = pk2(b.x, b.y); wu.w = pk2(b.z, b.w);
    bf16x8 wb = as_bf16x8(wu);
#pragma unroll
    for (int db = 0; db < 2; ++db) {
      bf16x8 va = *(const bf16x8*)(Vt + (db * 32 + r) * VSTR + ks * 16 + 8 * h);
      acc[db] = MFMA(va, wb, acc[db]);
    }
  }
  const float bias = p.chunk_b[(l * 4 + hd) * 128 + pp];
  const int token = tok0 + pp;
#pragma unroll
  for (int db = 0; db < 2; ++db)
#pragma unroll
    for (int g = 0; g < 4; ++g) {
      uint2 uu = *(const uint2*)(P + (size_t)token * PC + hd * 64 + db * 32 + 8 * g + 4 * h);
      acc[db][4 * g + 0] = bflo(uu.x) * (acc[db][4 * g + 0] + bias);
      acc[db][4 * g + 1] = bfhi(uu.x) * (acc[db][4 * g + 1] + bias);
      acc[db][4 * g + 2] = bflo(uu.y) * (acc[db][4 * g + 2] + bias);
      acc[db][4 * g + 3] = bfhi(uu.y) * (acc[db][4 * g + 3] + bias);
    }
  store_oT((bf16_t*)(p.ws + OFF_O), token, hd * 64, acc, h);
}

DI void mixer_d(const Params& p, int l, int ch, int g) {
  const int tid = opaque_tid(), lane = tid & 63, wave = tid >> 6, r = lane & 31, h = lane >> 5;
  const bf16_t* P = (const bf16_t*)(p.ws + OFF_P);
  const int token = ch * 128 + wave * 32 + r;
  int s0, slen;
  if (token < TCTX) { s0 = token & ~255; slen = 256; } else { s0 = TCTX + ((token - TCTX) & ~1023); slen = 1024; }
  const int pos = token - s0;
  const int w = 2 << g, hw = w >> 1;
  int lo = pos - hw; if (lo < 0) lo = 0;
  int hi = pos + hw; if (hi > slen) hi = slen;
  const float icnt = 1.f / (float)(hi - lo);
  const float* wp = p.pool_w + (size_t)(l * 4 + g) * 64 * 64;
  f32x16 acc[2];
#pragma unroll
  for (int db = 0; db < 2; ++db)
#pragma unroll
    for (int e = 0; e < 16; ++e) acc[db][e] = 0.f;
#pragma unroll
  for (int ks = 0; ks < 4; ++ks) {
    const int cbase = 1792 + g * 64 + ks * 16 + 8 * h;
    float sum[8];
#pragma unroll
    for (int k = 0; k < 8; ++k) sum[k] = 0.f;
    for (int i = 0; i < w; ++i) {
      int tt = pos - hw + i;
      if (tt >= 0 && tt < slen) {
        uint4 v = *(const uint4*)(P + (size_t)(s0 + tt) * PC + cbase);
        sum[0] += bflo(v.x); sum[1] += bfhi(v.x); sum[2] += bflo(v.y); sum[3] += bfhi(v.y);
        sum[4] += bflo(v.z); sum[5] += bfhi(v.z); sum[6] += bflo(v.w); sum[7] += bfhi(v.w);
      }
    }
    uint4 zv = *(const uint4*)(P + (size_t)token * PC + cbase);
    float z[8] = {bflo(zv.x), bfhi(zv.x), bflo(zv.y), bfhi(zv.y), bflo(zv.z), bfhi(zv.z), bflo(zv.w), bfhi(zv.w)};
    float pl[8];
#pragma unroll
    for (int k = 0; k < 8; ++k) pl[k] = sum[k] * icnt - z[k];
    bf16x8 pb = as_bf16x8(pack8(pl));
#pragma unroll
    for (int db = 0; db < 2; ++db) {
      float wv[8];
#pragma unroll
      for (int k = 0; k < 8; ++k) wv[k] = wp[(ks * 16 + 8 * h + k) * 64 + db * 32 + r];
      bf16x8 wa = as_bf16x8(pack8(wv));
      acc[db] = MFMA(wa, pb, acc[db]);
    }
  }
#pragma unroll
  for (int db = 0; db < 2; ++db)
#pragma unroll
    for (int e = 0; e < 16; ++e) acc[db][e] *= p.pool_scale[l * 256 + g * 64 + db * 32 + crow(e, h)];
  store_oT((bf16_t*)(p.ws + OFF_O), token, 768 + g * 64, acc, h);
}

DI void phase_mixers(const Grp& gr, int nshard, const Params& p, int l, char* smem, int* ctr) {
  bool qfirst = true;
  for (;;) {
    const int it = next_item(gr, ctr, smem, qfirst, nshard);
    if (it >= 480) break;
    if (it < 288) {
      bool lat, cmix; int b, hd, qb;
      if (it < 64) { int q = it; lat = true; cmix = true; b = gr.g; hd = (q >> 4) & 3; qb = q & 15; }
      else if (it < 96) { int q = it - 64; lat = true; cmix = false; b = gr.g; hd = ((q >> 4) & 1) * 2; qb = q & 15; }
      else if (it < 224) { int q = it - 96; lat = false; cmix = true; b = gr.g * 8 + (q >> 4); hd = (q >> 2) & 3; qb = q & 3; }
      else { int q = it - 224; lat = false; cmix = false; b = gr.g * 8 + (q >> 3); hd = ((q >> 2) & 1) * 2; qb = q & 3; }
      mixer_bc(p, l, cmix, lat, b, hd, qb, smem);
    } else if (it < 384) { int q = it - 288; mixer_a(p, l, mtile_g(gr.g, q >> 2), q & 3, smem); }
    else { int q = it - 384; mixer_d(p, l, mtile_g(gr.g, q >> 2), q & 3); }
  }
}

constexpr int PKSTR = 68;
constexpr int PKJ = 128 * PKSTR + 16;

typedef float f32x4 __attribute__((ext_vector_type(4)));
DI void phase_peer(const Grp& gr, const Params& p, int l, char* smem, bool dry) {
  const int tid = opaque_tid(), lane = tid & 63, wave = tid >> 6;
  unsigned* scr3 = (unsigned*)smem + wave * 1024;
  unsigned* eidx = scr3 + 768;
  float* egate = (float*)(scr3 + 896);
  __syncthreads();
  int ci = 0, cj = 0;
  {
    int L = lane, i = 0;
    while (i < 16 && L >= 16 / (i + 1)) { L -= 16 / (i + 1); ++i; }
    ci = i; cj = L;
  }
  const bool cvalid = lane < 50;
  if (!cvalid) { ci = 0; cj = 0; }
  const float* X = (const float*)(p.ws + OFF_X);
  float* Xw = (float*)(p.ws + (dry ? OFF_X2 : OFF_X));
  const bf16_t* Qb = (const bf16_t*)(p.ws + OFF_Q);
  const bf16_t* KB = (const bf16_t*)(p.ws + OFF_KEYB) + (size_t)l * 2 * 128 * 64;
  const bf16_t* H = (const bf16_t*)(p.ws + OFF_H);
  bf16_t* Hw = (bf16_t*)(p.ws + (dry ? OFF_H2 : OFF_H));
  float* Yw = dry ? (float*)(p.ws + OFF_X2) : p.out + OUT_Y;
  const float* mod = (const float*)(p.ws + OFF_MOD);
  const unsigned char* U8 = (const unsigned char*)(p.ws + OFF_UB) + (size_t)l * NEXP * 2048;
  const unsigned char* V8 = U8 + 1024;
  const float* USC = (const float*)(p.ws + OFF_USC) + (size_t)l * NEXP;
  const float* VSC = (const float*)(p.ws + OFF_VSC) + (size_t)l * NEXP;
  const int gw = gr.lq * 4 + wave, nw = gr.QB * 4;
  const int q0 = gr.j * QTOK;
#pragma unroll 1
  for (int tb = gw; tb < QTOK; tb += 3 * nw) {
    {
      const int c16 = lane & 15, quad = lane >> 4;
#pragma unroll 1
      for (int jc = 0; jc < 4; ++jc) {
        const int j = jc >> 1, c = (jc & 1) * 16 + c16;
        int ti = c >> 3; if (ti > 2) ti = 2;
        const int hh = c & 7;
        int tok = tb + ti * nw; if (tok >= QTOK) tok = tb;
        tok = tok_g(gr.g, q0 + tok);
        const bf16_t* qp = Qb + (size_t)tok * DM + hh * 128 + j * 64 + quad * 8;
        const bf16x8 b0 = *(const bf16x8*)qp, b1 = *(const bf16x8*)(qp + 32);
        const bf16_t* kp = KB + (size_t)(j * 128 + c16) * 64 + quad * 8;
        float top[16];
#pragma unroll
        for (int s = 0; s < 16; ++s) top[s] = -3.0e38f;
#pragma unroll
        for (int nb = 0; nb < 8; ++nb) {
          const bf16x8 a0 = *(const bf16x8*)(kp + nb * 16 * 64), a1 = *(const bf16x8*)(kp + nb * 16 * 64 + 32);
          f32x4 acc = {0.f, 0.f, 0.f, 0.f};
          acc = __builtin_amdgcn_mfma_f32_16x16x32_bf16(a0, b0, acc, 0, 0, 0);
          acc = __builtin_amdgcn_mfma_f32_16x16x32_bf16(a1, b1, acc, 0, 0, 0);
#pragma unroll
          for (int e = 0; e < 4; ++e) {
            float v = __uint_as_float((__float_as_uint(acc[e]) & ~0x7Fu) | (unsigned)(nb * 16 + quad * 4 + e));
#pragma unroll
            for (int s = 0; s < 16; ++s) {
              float hi_ = fmaxf(top[s], v);
              v = fminf(top[s], v);
              top[s] = hi_;
            }
          }
        }
#pragma unroll
        for (int step = 16; step <= 32; step <<= 1) {
          float oth[16];
#pragma unroll
          for (int s = 0; s < 16; ++s) oth[s] = __shfl_xor(top[s], step);
#pragma unroll
          for (int s = 0; s < 16; ++s) top[s] = fmaxf(top[s], oth[15 - s]);
#pragma unroll
          for (int dist = 8; dist >= 1; dist >>= 1) {
#pragma unroll
            for (int s = 0; s < 16; ++s) {
              if ((s & dist) == 0) {
                float a = top[s], b = top[s + dist];
                top[s] = fmaxf(a, b);
                top[s + dist] = fminf(a, b);
              }
            }
          }
        }
        if (quad == 0 && c < 24) {
          unsigned* dstp = scr3 + ((c >> 3) * 16 + 2 * hh + j) * 16;
#pragma unroll
          for (int s4 = 0; s4 < 4; ++s4)
            *(uint4*)(dstp + s4 * 4) = make_uint4(__float_as_uint(top[s4 * 4 + 0]), __float_as_uint(top[s4 * 4 + 1]),
                                                  __float_as_uint(top[s4 * 4 + 2]), __float_as_uint(top[s4 * 4 + 3]));
        }
      }
    }
    __builtin_amdgcn_fence(__ATOMIC_RELEASE, "wavefront");
    __builtin_amdgcn_wave_barrier();
    __builtin_amdgcn_fence(__ATOMIC_ACQUIRE, "wavefront");
#pragma unroll 1
    for (int ti3 = 0; ti3 < 3; ++ti3) {
    if (tb + ti3 * nw >= QTOK) break;
    const int t = tok_g(gr.g, q0 + tb + ti3 * nw);
    unsigned* scr = scr3 + ti3 * 256;
    for (int hd = 0; hd < 8; ++hd) {
      unsigned ka = scr[(2 * hd) * 16 + ci], kb = scr[(2 * hd + 1) * 16 + cj];
      float cand = cvalid ? (__uint_as_float(ka & ~0x7Fu) + __uint_as_float(kb & ~0x7Fu)) : -3.0e38f;
      int rank = 0;
#pragma unroll
      for (int m = 0; m < 50; ++m) {
        float sv = __uint_as_float(__builtin_amdgcn_readlane(__float_as_uint(cand), m));
        rank += (sv > cand) ? 1 : 0;
      }
      bool sel = cvalid && rank < 16;
      unsigned long long bm = __ballot(sel);
      int slot = __builtin_amdgcn_mbcnt_hi((unsigned)(bm >> 32), __builtin_amdgcn_mbcnt_lo((unsigned)bm, 0));
      unsigned long long b0 = __ballot(cvalid && rank == 0);
      int l0 = __ffsll((long long)b0) - 1;
      float mx = __uint_as_float(__builtin_amdgcn_readlane(__float_as_uint(cand), l0));
      float e = sel ? __expf(cand - mx) : 0.f;
      float sum = wave_sum(e);
      if (sel && slot < 16) {
        eidx[hd * 16 + slot] = (ka & 0x7Fu) * 128u + (kb & 0x7Fu);
        egate[hd * 16 + slot] = e / sum;
      }
    }
    __builtin_amdgcn_fence(__ATOMIC_RELEASE, "wavefront");
    __builtin_amdgcn_wave_barrier();
    __builtin_amdgcn_fence(__ATOMIC_ACQUIRE, "wavefront");
    const float* modv = mod + (size_t)(l * 3 + tok_grp(t)) * 6144;
    f2v_t h2[8], outp[8];
    {
#pragma unroll
      for (int j = 0; j < 4; ++j) {
        const uint2 hu = *(const uint2*)(H + (size_t)t * DM + j * 256 + lane * 4);
        h2[2 * j] = f2v_t{bflo(hu.x), bfhi(hu.x)};
        h2[2 * j + 1] = f2v_t{bflo(hu.y), bfhi(hu.y)};
      }
#pragma unroll
      for (int w = 0; w < 8; ++w) outp[w] = f2v_t{0.f, 0.f};
    }
    {
      float* eus = (float*)scr;
#pragma unroll
      for (int j = 0; j < 2; ++j) {
        const int i = lane + 64 * j;
        const unsigned id = eidx[i];
        eus[i] = USC[id];
        eus[128 + i] = egate[i] * VSC[id];
      }
    }
    __builtin_amdgcn_fence(__ATOMIC_RELEASE, "wavefront");
    __builtin_amdgcn_wave_barrier();
    __builtin_amdgcn_fence(__ATOMIC_ACQUIRE, "wavefront");
    const float* eus = (const float*)scr;
    u32x4 ub[16], vb[16];
#pragma unroll 1
    for (int hd = 0; hd < 8; ++hd) {
#pragma unroll
      for (int k = 0; k < 16; ++k) {
        unsigned id = __builtin_amdgcn_readfirstlane(eidx[hd * 16 + k]);
        ub[k] = *(const u32x4*)(U8 + ((size_t)id << 11) + lane * 16);
      }
#pragma unroll
      for (int k = 0; k < 16; ++k) {
        unsigned id = __builtin_amdgcn_readfirstlane(eidx[hd * 16 + k]);
        vb[k] = *(const u32x4*)(V8 + ((size_t)id << 11) + lane * 16);
      }
      float pd[16];
#pragma unroll
      for (int k = 0; k < 16; ++k) {
        f2v_t acc = {0.f, 0.f};
#pragma unroll
        for (int w = 0; w < 4; ++w) {
          acc = __builtin_elementwise_fma(__builtin_amdgcn_cvt_pk_f32_fp8((int)ub[k][w], false), h2[2 * w], acc);
          acc = __builtin_elementwise_fma(__builtin_amdgcn_cvt_pk_f32_fp8((int)ub[k][w], true), h2[2 * w + 1], acc);
        }
        pd[k] = acc.x + acc.y;
      }
      const bool b0 = lane & 1, b1 = lane & 2, b2 = lane & 4, b3 = lane & 8;
      float w8[8], w4[4], w2[2], z;
#pragma unroll
      for (int i = 0; i < 8; ++i) { float snd = b0 ? pd[i] : pd[8 + i], kp = b0 ? pd[8 + i] : pd[i]; w8[i] = kp + __shfl_xor(snd, 1); }
#pragma unroll
      for (int i = 0; i < 4; ++i) { float snd = b1 ? w8[i] : w8[4 + i], kp = b1 ? w8[4 + i] : w8[i]; w4[i] = kp + __shfl_xor(snd, 2); }
#pragma unroll
      for (int i = 0; i < 2; ++i) { float snd = b2 ? w4[i] : w4[2 + i], kp = b2 ? w4[2 + i] : w4[i]; w2[i] = kp + __shfl_xor(snd, 4); }
      { float snd = b3 ? w2[0] : w2[1], kp = b3 ? w2[1] : w2[0]; z = kp + __shfl_xor(snd, 8); }
      z += __shfl_xor(z, 16); z += __shfl_xor(z, 32);
      const int kmine = ((lane & 1) << 3) | ((lane & 2) << 1) | ((lane & 4) >> 1) | ((lane & 8) >> 3);
      const float cfl = eus[128 + hd * 16 + kmine] * gelu_t(z * eus[hd * 16 + kmine]);
#pragma unroll
      for (int k = 0; k < 16; ++k) {
        const int src = ((k >> 3) & 1) | (((k >> 2) & 1) << 1) | (((k >> 1) & 1) << 2) | ((k & 1) << 3);
        const float cf = __uint_as_float(__builtin_amdgcn_readlane(__float_as_uint(cfl), src));
        const f2v_t c2 = {cf, cf};
#pragma unroll
        for (int w = 0; w < 4; ++w) {
          outp[2 * w] = __builtin_elementwise_fma(__builtin_amdgcn_cvt_pk_f32_fp8((int)vb[k][w], false), c2, outp[2 * w]);
          outp[2 * w + 1] = __builtin_elementwise_fma(__builtin_amdgcn_cvt_pk_f32_fp8((int)vb[k][w], true), c2, outp[2 * w + 1]);
        }
      }
    }
    float x1[16], outv[16];
#pragma unroll
    for (int w = 0; w < 8; ++w) { outv[2 * w] = outp[w].x; outv[2 * w + 1] = outp[w].y; }
    load_row16(X + (size_t)t * DM, lane, x1);
    {
      float g2[16], g[16], bb[16];
      load_row16(modv + 5120, lane, g2);
      load_row16(p.ln_g + (size_t)(l * 2 + 1) * DM, lane, g);
      load_row16(p.ln_b + (size_t)(l * 2 + 1) * DM, lane, bb);
#pragma unroll
      for (int i = 0; i < 16; ++i) x1[i] = ALPHA * x1[i] + g2[i] * outv[i];
      float mu, rstd;
      ln_stats(x1, mu, rstd);
#pragma unroll
      for (int i = 0; i < 16; ++i) x1[i] = (x1[i] - mu) * rstd * g[i] + bb[i];
      if (l == DEPTH - 1) {
        {
          typedef float f32x4s __attribute__((ext_vector_type(4)));
#pragma unroll
          for (int j = 0; j < 4; ++j) {
            const f32x4s tv = {x1[4 * j], x1[4 * j + 1], x1[4 * j + 2], x1[4 * j + 3]};
            __builtin_nontemporal_store(tv, (f32x4s*)(Yw + (size_t)t * DM + j * 256 + lane * 4));
          }
        }
      } else {
        store_row16(Xw + (size_t)t * DM, lane, x1);
        const float* modn = mod + (size_t)((l + 1) * 3 + tok_grp(t)) * 6144;
        ln_stats(x1, mu, rstd);
        float sh[16], scv[16];
        load_row16(modn, lane, sh);
        load_row16(modn + 1024, lane, scv);
#pragma unroll
        for (int i = 0; i < 16; ++i) x1[i] = (x1[i] - mu) * rstd * (1.f + scv[i]) + sh[i];
#pragma unroll
        for (int j = 0; j < 4; ++j) {
          uint2 hu; hu.x = pk2(x1[4 * j], x1[4 * j + 1]); hu.y = pk2(x1[4 * j + 2], x1[4 * j + 3]);
          *(uint2*)(Hw + (size_t)t * DM + j * 256 + lane * 4) = hu;
        }
      }
    }
    }
  }
}

struct EpiG1 {
  const Params* p; int l;
  DI void operator()(int rb, int cb, const f32x16& acc, int r, int h) const {
    bf16_t* P = (bf16_t*)(p->ws + OFF_P);
    const int col = cb + r;
    const bool lat = rb >= TCTX;
    float v[16];
#pragma unroll
    for (int e = 0; e < 16; ++e) v[e] = acc[e];
    if (cb < 512) {
#pragma unroll
      for (int e = 0; e < 16; ++e) v[e] = gelu_t(v[e]);
    } else if (lat) {
      const bool ropeB = (cb < 896);
      const bool ropeC = (cb >= 1024 && cb < 1536);
      if (ropeB || ropeC) {
        const int dim = ropeB ? 64 : 32, q = ropeB ? 16 : 8;
        const float* tab = (const float*)(p->ws + (ropeB ? OFF_ROPEB : OFF_ROPEC));
        const int di = col & (dim - 1);
        const bool up = (di & q) != 0;
#pragma unroll
        for (int e = 0; e < 16; ++e) {
          int pos = (rb + crow(e, h) - TCTX) & 1023;
          float partner = __shfl_xor(v[e], q);
          float cs = tab[pos * dim + di], sn = tab[1024 * dim + pos * dim + di];
          v[e] = v[e] * cs + (up ? partner : -partner) * sn;
        }
      }
    }
#pragma unroll
    for (int e = 0; e < 16; ++e) {
      if (cb < 768 || (cb >= 1024 && cb < 1280)) __builtin_nontemporal_store(f2bf(v[e]), &P[(size_t)(rb + crow(e, h)) * PC + col]);
      else P[(size_t)(rb + crow(e, h)) * PC + col] = f2bf(v[e]);
    }
    if (!lat) {
      float* dst = nullptr; int width = 0, c0 = 0;
      if (cb >= 768 && cb < 896) { dst = p->out + OUT_WK; width = 128; c0 = 768; }
      else if (cb >= 896 && cb < 1024) { dst = p->out + OUT_WV; width = 128; c0 = 896; }
      else if (cb >= 1280 && cb < 1536) { dst = p->out + OUT_DK; width = 256; c0 = 1280; }
      else if (cb >= 1536 && cb < 1792) { dst = p->out + OUT_DV; width = 256; c0 = 1536; }
      if (dst) {
#pragma unroll
        for (int e = 0; e < 16; ++e) {
          int t = rb + crow(e, h), b = t >> 8, s = t & 255;
          __builtin_nontemporal_store(v[e], &dst[((size_t)(b * DEPTH + l) * 256 + s) * width + (col - c0)]);
        }
      }
    }
  }
};
struct EpiG2 {
  const Params* p; int l; bool dry;
  DI void operator()(int rb, int cb, const f32x16& acc, int r, int h) const {
    const float* X = (const float*)(p->ws + OFF_X);
    float* Xo = (float*)(p->ws + (dry ? OFF_X2 : OFF_X));
    const int col = cb + r;
    const float g1 = ((const float*)(p->ws + OFF_MOD))[(size_t)(l * 3 + tok_grp(rb)) * 6144 + 2048 + col];
#pragma unroll
    for (int e = 0; e < 16; ++e) {
      size_t idx = (size_t)(rb + crow(e, h)) * DM + col;
      Xo[idx] = ALPHA * X[idx] + g1 * acc[e];
    }
  }
};
struct EpiG3 {
  const Params* p;
  DI void operator()(int rb, int cb, const f32x16& acc, int r, int h) const {
    bf16_t* Q = (bf16_t*)(p->ws + OFF_Q);
    const int col = cb + r;
#pragma unroll
    for (int e = 0; e < 16; ++e) Q[(size_t)(rb + crow(e, h)) * DM + col] = f2bf(acc[e]);
  }
};

#define XB_TMO      128
#define XB_XCNT(j)  (256  + 64 * (j))
#define XB_XSUB(j)  (1280 + 64 * (j))
#define XB_XGEN(j)  (2304 + 64 * (j))
#define XB_TOP      3328
#define XB_TOPGEN   3392
#define XCD_BAR_WORDS 3456
#define XB_SPIN_CAP (1u << 18)
#define LAS __attribute__((address_space(3)))
DI unsigned xb_ld(unsigned* p) { return __hip_atomic_load(p, __ATOMIC_RELAXED, __HIP_MEMORY_SCOPE_AGENT); }
DI unsigned xb_add(unsigned* p, unsigned v) { return __hip_atomic_fetch_add(p, v, __ATOMIC_RELAXED, __HIP_MEMORY_SCOPE_AGENT); }
DI unsigned xb_xcc_id() { return (unsigned)__builtin_amdgcn_s_getreg((3 << 11) | 20) & 0xFu; }
#define XB_SPIN(cond, bar) do { unsigned _sp = 0; while (cond) { __builtin_amdgcn_s_sleep(1); \
    if ((++_sp & 255u) == 0u) { if (xb_ld(&(bar)[XB_TMO])) break; if (_sp > XB_SPIN_CAP) { atomicAdd(&(bar)[XB_TMO], 1u); break; } } } } while (0)
struct XcdBarrier { unsigned* bar; unsigned x; volatile LAS unsigned* st; };
DI XcdBarrier xcd_barrier_post(unsigned* bar, volatile LAS unsigned* st) {
  XcdBarrier b; b.bar = bar; b.x = xb_xcc_id(); b.st = st;
  if (threadIdx.x == 0) (void)xb_add(&bar[XB_XCNT(b.x)], 1u);
  return b;
}
DI void xcd_barrier_complete(unsigned* bar, unsigned x, unsigned& nloc, unsigned& nx, unsigned G) {
  unsigned sum, cnt, mine, sp = 0u;
  for (;;) {
    sum = 0u; cnt = 0u; mine = 0u;
#pragma unroll
    for (unsigned j = 0; j < 16; ++j) { const unsigned c = xb_ld(&bar[XB_XCNT(j)]); sum += c; cnt += (c > 0u) ? 1u : 0u; mine = (j == x) ? c : mine; }
    if (sum == G) break;
    __builtin_amdgcn_s_sleep(1);
    if ((++sp & 255u) == 0u) { if (xb_ld(&bar[XB_TMO])) break; if (sp > XB_SPIN_CAP) { atomicAdd(&bar[XB_TMO], 1u); break; } }
  }
  nloc = mine > 0u ? mine : 1u; nx = cnt > 0u ? cnt : 1u;
}
DI void xcd_barrier(unsigned* bar_, volatile LAS unsigned* st_, unsigned G) {
  XcdBarrier b; b.bar = bar_; b.x = xb_xcc_id(); b.st = st_;
  asm volatile("s_waitcnt vmcnt(0)" ::: "memory");
  __syncthreads();
  if (threadIdx.x == 0) {
    unsigned* bar = b.bar;
    __builtin_amdgcn_s_waitcnt(0);
    unsigned nloc = b.st[0], nx = b.st[1];
    if (nloc == 0u) { xcd_barrier_complete(bar, b.x, nloc, nx, G); b.st[0] = nloc; b.st[1] = nx; }
    const unsigned old = xb_add(&bar[XB_XSUB(b.x)], 1u);
    const unsigned gen = old / nloc;
    if (old + 1u == (gen + 1u) * nloc) {
      __builtin_amdgcn_fence(__ATOMIC_RELEASE, "agent");
      asm volatile("s_waitcnt vmcnt(0)" ::: "memory");
      const unsigned og = xb_add(&bar[XB_TOP], 1u);
      const unsigned tg = og / nx;
      if (og + 1u == (tg + 1u) * nx) xb_add(&bar[XB_TOPGEN], 1u);
      else XB_SPIN(xb_ld(&bar[XB_TOPGEN]) == tg, bar);
      __builtin_amdgcn_fence(__ATOMIC_ACQUIRE, "agent");
      xb_add(&bar[XB_XGEN(b.x)], 1u);
      asm volatile("s_waitcnt vmcnt(0)" ::: "memory");
    } else {
      XB_SPIN(xb_ld(&bar[XB_XGEN(b.x)]) == gen, bar);
      __builtin_amdgcn_fence(__ATOMIC_ACQUIRE, "agent");
      asm volatile("s_waitcnt vmcnt(0)" ::: "memory");
    }
  }
  __syncthreads();
}

constexpr int SMEM_BYTES = 78848;
static_assert(SMEM_BYTES >= 4 * 1024 * 4, "peer smem");
static_assert(SMEM_BYTES >= 2 * 2 * 128 * GSTR * 2, "gemm smem");
static_assert(SMEM_BYTES >= (128 * KSTR + 64 * VSTR) * 2, "attn smem");

__global__ void __launch_bounds__(NTHR, 2) fwd_megakernel(Params p) {
  __shared__ __attribute__((aligned(16))) char smem[SMEM_BYTES];
  __shared__ uint4 xb_words, xg_words;
  cg::grid_group grid = cg::this_grid();
  if (threadIdx.x == 0) { xb_words = make_uint4(0u, 0u, 0u, 0u); xg_words = make_uint4(0u, 0u, 0u, 0u); }
  __syncthreads();
  const Grp gr = my_grp();
  unsigned* gbar = (unsigned*)(p.ws + OFF_BAR);
  unsigned* mbar = (unsigned*)(p.ws + OFF_BAR + (size_t)(1 + gr.g) * 16384);
  unsigned* flag = (unsigned*)(p.ws + OFF_BAR + 3 * 16384);
  (void)xcd_barrier_post(gbar, (volatile LAS unsigned*)&xb_words);
  (void)xcd_barrier_post(mbar, (volatile LAS unsigned*)&xg_words);
  if (p.ws == nullptr) grid.sync();
#define GBARRIER() xcd_barrier(gbar, (volatile LAS unsigned*)&xb_words, gridDim.x)
#define MBARRIER() xcd_barrier(mbar, (volatile LAS unsigned*)&xg_words, (unsigned)gr.GB)
  phase0(p, smem);
  GBARRIER();
  const int nshard = 8;
  phase_modreduce(p);
  GBARRIER();
  phase_ln0(p);
  GBARRIER();
  if (SPLIT_OFFSET && gr.g == 1) {
    convert_tables(p, 2 * NEXP, 4 * NEXP, gr.lb * 4 + (int)(threadIdx.x >> 6), gr.GB * 4);
    __threadfence();
    __syncthreads();
    if (threadIdx.x == 0) atomicAdd(flag, 1u);
  }
  int* ctr = (int*)(p.ws + OFF_QCTR) + gr.g * (32 * 512);
  for (int l = 0; l < DEPTH; ++l) {
    gemm_phase(gr, nshard, (const bf16_t*)(p.ws + OFF_H), (const bf16_t*)(p.ws + OFF_WINT) + (size_t)l * PC * DM, PC, smem, ctr + ((l * 4 + 0) * 2) * 512, EpiG1{&p, l});
    MBARRIER();
    phase_mixers(gr, nshard, p, l, smem, ctr + ((l * 4 + 1) * 2) * 512);
    MBARRIER();
    gemm_phase(gr, nshard, (const bf16_t*)(p.ws + OFF_O), (const bf16_t*)(p.ws + OFF_WOUTT) + (size_t)l * DM * DM, DM, smem, ctr + ((l * 4 + 2) * 2) * 512, EpiG2{&p, l, false});
    MBARRIER();
    phase_ln1(gr, p, l, false);
    MBARRIER();
    gemm_phase(gr, nshard, (const bf16_t*)(p.ws + OFF_H), (const bf16_t*)(p.ws + OFF_WQT) + (size_t)l * DM * DM, DM, smem, ctr + ((l * 4 + 3) * 2) * 512, EpiG3{&p});
    if (SPLIT_OFFSET && l == 2 && gr.g == 0) {
      if (threadIdx.x == 0) { XB_SPIN(xb_ld(flag) < (unsigned)gr.GB, gbar); }
      __syncthreads();
    }
    MBARRIER();
    phase_peer(gr, p, l, smem, false);
    if (l + 1 < DEPTH) MBARRIER();
  }
}

extern "C" void kernel_launch(void* const* d_in, const int* in_sizes, int n_in, void* d_out, int out_size, void* d_ws,
                              size_t ws_size, hipStream_t stream) {
  static int grid_blocks = 0;
  if (!grid_blocks) {
    int dev = 0, cus = 0, per_cu = 0;
    (void)hipGetDevice(&dev);
    (void)hipDeviceGetAttribute(&cus, hipDeviceAttributeMultiprocessorCount, dev);
    (void)hipOccupancyMaxActiveBlocksPerMultiprocessor(&per_cu, fwd_megakernel, NTHR, 0);
    if (per_cu > 2) per_cu = 2;
    if (per_cu < 1) per_cu = 1;
    grid_blocks = cus * per_cu;
  }
  Params p{};
  const float** pp = (const float**)&p;
  for (int i = 0; i < 26; ++i) pp[i] = (const float*)d_in[i];
  p.out = (float*)d_out;
  p.ws = (char*)d_ws;
  void* args[] = {&p};
  (void)hipMemsetAsync((char*)d_ws + OFF_BAR, 0, 4 * 16384, stream);
  hipError_t e = hipLaunchCooperativeKernel((void*)fwd_megakernel, dim3(grid_blocks), dim3(NTHR), args, 0, stream);
  if (e != hipSuccess) fprintf(stderr, "cooperative launch failed: %s (grid %d)\n", hipGetErrorString(e), grid_blocks);
}
```

```cpp
#include <hip/hip_runtime.h>
#include <hip/hip_cooperative_groups.h>
#include <cstdio>
namespace cg = cooperative_groups;

#define DI __device__ __forceinline__
typedef short bf16x8 __attribute__((ext_vector_type(8)));
typedef short s16x4 __attribute__((ext_vector_type(4)));
typedef float f32x16 __attribute__((ext_vector_type(16)));
typedef unsigned short bf16_t;
typedef unsigned u32x4 __attribute__((ext_vector_type(4)));
#define MFMA(a, b, c) __builtin_amdgcn_mfma_f32_32x32x16_bf16((a), (b), (c), 0, 0, 0)

constexpr int DM = 1024, TCTX = 4096, TLAT = 2048, NT = 6144, PC = 2048, DEPTH = 4;
constexpr int NEXP = 16384;
constexpr float ALPHA = 1.681792830507429f;
constexpr float LN_EPS = 1e-5f;
constexpr int NTHR = 256;

constexpr size_t OUT_Y = 0;
constexpr size_t OUT_WK = 6291456, OUT_WV = 8388608, OUT_DK = 10485760, OUT_DV = 14680064;

constexpr size_t SZ_WINT = (size_t)DEPTH * PC * DM * 2;
constexpr size_t SZ_WSQ = (size_t)DEPTH * DM * DM * 2;
constexpr size_t SZ_TAB = (size_t)DEPTH * NEXP * DM * 2;
constexpr size_t OFF_WINT = 0;
constexpr size_t OFF_WOUTT = OFF_WINT + SZ_WINT;
constexpr size_t OFF_WQT = OFF_WOUTT + SZ_WSQ;
constexpr size_t OFF_UB = OFF_WQT + SZ_WSQ;
constexpr size_t OFF_VB = OFF_UB + SZ_TAB;
constexpr size_t OFF_X = OFF_VB + SZ_TAB;
constexpr size_t OFF_H = OFF_X + (size_t)NT * DM * 4;
constexpr size_t OFF_P = OFF_H + (size_t)NT * DM * 2;
constexpr size_t OFF_O = OFF_P + (size_t)NT * PC * 2;
constexpr size_t OFF_Q = OFF_O + (size_t)NT * DM * 2;
constexpr size_t OFF_MOD = OFF_Q + (size_t)NT * DM * 4;
constexpr size_t OFF_MODP = OFF_MOD + (size_t)DEPTH * 3 * 6144 * 4;
constexpr size_t OFF_ROPEB = OFF_MODP + (size_t)DEPTH * 16 * 3 * 6144 * 4;
constexpr size_t OFF_ROPEC = OFF_ROPEB + (size_t)1024 * 64 * 2 * 4;
constexpr size_t OFF_LAM = OFF_ROPEC + (size_t)1024 * 32 * 2 * 4;
constexpr size_t OFF_CTR = OFF_LAM + 256;
constexpr size_t OFF_CWKB = OFF_CTR + 1024;
constexpr size_t OFF_CWVB = OFF_CWKB + (size_t)2 * 4 * 256 * 128 * 2;
constexpr size_t OFF_CDKB = OFF_CWVB + (size_t)2 * 4 * 256 * 128 * 2;
constexpr size_t OFF_CDVB = OFF_CDKB + (size_t)2 * 4 * 256 * 256 * 2;
constexpr size_t OFF_USC = OFF_CDVB + (size_t)2 * 4 * 256 * 256 * 2;
constexpr size_t OFF_VSC = OFF_USC + (size_t)DEPTH * NEXP * 4;
constexpr size_t OFF_KEYB = OFF_VSC + (size_t)DEPTH * NEXP * 4;
constexpr size_t OFF_BAR = OFF_KEYB + (size_t)DEPTH * 2 * 128 * 64 * 2; constexpr size_t OFF_BAR_UNUSED = OFF_CDVB + (size_t)2 * 4 * 256 * 256 * 2;
constexpr size_t OFF_X2 = OFF_BAR + 4 * 16384;
constexpr size_t OFF_H2 = OFF_X2 + (size_t)NT * DM * 4;
constexpr size_t OFF_QCTR = OFF_H2 + (size_t)NT * DM * 2;
constexpr int REP_P0 = 1, REP_G1 = 1, REP_MIX = 1, REP_G2 = 1, REP_LN1 = 1, REP_G3 = 1, REP_PEER = 1;
constexpr int SLOT_OFF = 78000;

struct Params {
  const float *x_prompt, *x_sample, *c, *cwk, *cwv, *cdk, *cdv, *c_ctx, *w_mod, *b_mod, *w_in, *w_out, *chunk_w, *chunk_b,
      *win_sink, *lam_q, *lam_k, *subln_g, *pool_w, *pool_scale, *ln_g, *ln_b, *peer_wq, *peer_keys, *peer_u, *peer_v;
  float* out;
  char* ws;
};

typedef __bf16 bf2v_t __attribute__((ext_vector_type(2)));
typedef float f2v_t __attribute__((ext_vector_type(2)));
DI unsigned pk2(float a, float b) { f2v_t v = {a, b}; return __builtin_bit_cast(unsigned, __builtin_convertvector(v, bf2v_t)); }
DI unsigned short f2bf(float x) { return (unsigned short)(pk2(x, 0.f) & 0xffffu); }
DI float bflo(unsigned u) { return __uint_as_float(u << 16); }
DI float bfhi(unsigned u) { return __uint_as_float(u & 0xffff0000u); }
DI float gelu_t(float x) { return x / (1.f + __expf(-1.5957691216057308f * (x + 0.044715f * x * x * x))); }
DI float wave_sum(float v) {
#pragma unroll
  for (int o = 32; o; o >>= 1) v += __shfl_xor(v, o);
  return v;
}
typedef __bf16 bf2_t __attribute__((ext_vector_type(2)));
DI float dot2bf(unsigned a, unsigned b, float c) { return __builtin_amdgcn_fdot2_f32_bf16(__builtin_bit_cast(bf2_t, a), __builtin_bit_cast(bf2_t, b), c, false); }
typedef float f32x4nt_t __attribute__((ext_vector_type(4)));
DI float4 ld_nt4(const float* p) { const f32x4nt_t t = __builtin_nontemporal_load((const f32x4nt_t*)p); return make_float4(t[0], t[1], t[2], t[3]); }
DI int opaque_tid() { int t = threadIdx.x; asm volatile("" : "+v"(t)); return t; }
struct Grp { int g, lb, GB, j, lq, QB; };
DI Grp my_grp() { Grp r; r.GB = (int)gridDim.x >> 1; r.g = (int)blockIdx.x & 1; r.lb = (int)blockIdx.x >> 1; r.j = r.lb & 3; r.lq = r.lb >> 2; r.QB = r.GB >> 2; return r; }
DI int mtile_g(int g, int mt) { return mt < 16 ? g * 16 + mt : 32 + g * 8 + (mt - 16); }
DI int tok_g(int g, int u) { return u < 2048 ? g * 2048 + u : TCTX + g * 1024 + (u - 2048); }
constexpr int GTOK = 3072;
constexpr int QTOK = 768;
constexpr bool SPLIT_OFFSET = true;
DI int next_tile_q(const Grp& gr, int* ctrq, char* smem, bool& first) {
  int* slot = (int*)(smem + SLOT_OFF);
  if (first) { first = false; return gr.lq; }
  __syncthreads();
  if (threadIdx.x == 0) *slot = gr.QB + atomicAdd(ctrq, 1);
  __syncthreads();
  return *slot;
}
DI int next_item(const Grp& gr, int* ctr, char* smem, bool& first, int nshard) {
  int* slot = (int*)(smem + SLOT_OFF);
  if (first) { first = false; return gr.lb; }
  __syncthreads();
  if (threadIdx.x == 0) {
    const int q = (nshard == 8) ? (gr.lb & 7) : 0;
    *slot = gr.GB + q + nshard * atomicAdd(ctr + q * 64, 1);
  }
  __syncthreads();
  return *slot;
}
DI int crow(int reg, int h) { return (reg & 3) + 8 * (reg >> 2) + 4 * h; }
DI uint4 pack8(const float* v) {
  uint4 r;
  r.x = pk2(v[0], v[1]); r.y = pk2(v[2], v[3]); r.z = pk2(v[4], v[5]); r.w = pk2(v[6], v[7]);
  return r;
}
DI bf16x8 as_bf16x8(uint4 u) { return __builtin_bit_cast(bf16x8, u); }

DI void load_row(const float* p, int lane, float (&v)[16]) {
#pragma unroll
  for (int c = 0; c < 2; ++c) {
    float4 a = *(const float4*)(p + c * 512 + lane * 8);
    float4 b = *(const float4*)(p + c * 512 + lane * 8 + 4);
    v[c * 8 + 0] = a.x; v[c * 8 + 1] = a.y; v[c * 8 + 2] = a.z; v[c * 8 + 3] = a.w;
    v[c * 8 + 4] = b.x; v[c * 8 + 5] = b.y; v[c * 8 + 6] = b.z; v[c * 8 + 7] = b.w;
  }
}
DI void store_row(float* p, int lane, const float (&v)[16]) {
#pragma unroll
  for (int c = 0; c < 2; ++c) {
    *(float4*)(p + c * 512 + lane * 8) = make_float4(v[c * 8 + 0], v[c * 8 + 1], v[c * 8 + 2], v[c * 8 + 3]);
    *(float4*)(p + c * 512 + lane * 8 + 4) = make_float4(v[c * 8 + 4], v[c * 8 + 5], v[c * 8 + 6], v[c * 8 + 7]);
  }
}
DI void store_row_bf(bf16_t* p, int lane, const float (&v)[16]) {
#pragma unroll
  for (int c = 0; c < 2; ++c) *(uint4*)(p + c * 512 + lane * 8) = pack8(&v[c * 8]);
}
DI void load_row16(const float* p, int lane, float (&v)[16]) {
#pragma unroll
  for (int j = 0; j < 4; ++j) {
    float4 a = *(const float4*)(p + j * 256 + lane * 4);
    v[4 * j] = a.x; v[4 * j + 1] = a.y; v[4 * j + 2] = a.z; v[4 * j + 3] = a.w;
  }
}
DI void store_row16(float* p, int lane, const float (&v)[16]) {
#pragma unroll
  for (int j = 0; j < 4; ++j) *(float4*)(p + j * 256 + lane * 4) = make_float4(v[4 * j], v[4 * j + 1], v[4 * j + 2], v[4 * j + 3]);
}
DI void ln_stats(const float (&v)[16], float& mu, float& rstd) {
  float s = 0.f;
#pragma unroll
  for (int i = 0; i < 16; ++i) s += v[i];
  s = wave_sum(s);
  mu = s * (1.f / 1024.f);
  float q = 0.f;
#pragma unroll
  for (int i = 0; i < 16; ++i) { float d = v[i] - mu; q += d * d; }
  q = wave_sum(q);
  rstd = rsqrtf(q * (1.f / 1024.f) + LN_EPS);
}
DI int tok_grp(int t) { return t < TCTX ? 0 : 1 + ((t - TCTX) >> 10); }
DI void ln_mod_to_bf(const float (&v)[16], const float* modv, int shoff, bf16_t* dst, int lane) {
  float mu, rstd;
  ln_stats(v, mu, rstd);
  float sh[16], sc[16], h[16];
  load_row(modv + shoff, lane, sh);
  load_row(modv + shoff + 1024, lane, sc);
#pragma unroll
  for (int i = 0; i < 16; ++i) h[i] = (v[i] - mu) * rstd * (1.f + sc[i]) + sh[i];
  store_row_bf(dst, lane, h);
}

DI void convert_tables(const Params& p, int r0, int r1, int gw, int nw) {
  char* ws = p.ws;
  const int lane = opaque_tid() & 63;
  const int nrow = r1 - r0;
  for (int bi = gw * 4; bi < 2 * nrow; bi += nw * 4) {
    const int tb = bi >= nrow ? 1 : 0;
    const int row = r0 + (bi - tb * nrow);
    const float* src = (tb ? p.peer_v : p.peer_u) + ((size_t)row << 10) + lane * 4;
    unsigned char* dst = (unsigned char*)(ws + OFF_UB) + ((size_t)row << 11) + tb * 1024 + lane * 16;
    float* sc = (float*)(ws + (tb ? OFF_VSC : OFF_USC)) + row;
    float4 x[4][4];
#pragma unroll
    for (int rr = 0; rr < 4; ++rr)
#pragma unroll
      for (int j = 0; j < 4; ++j) x[rr][j] = ld_nt4(src + (size_t)rr * 1024 + j * 256);
#pragma unroll
    for (int rr = 0; rr < 4; ++rr) {
      float am = 0.f;
#pragma unroll
      for (int j = 0; j < 4; ++j) am = fmaxf(am, fmaxf(fmaxf(fabsf(x[rr][j].x), fabsf(x[rr][j].y)), fmaxf(fabsf(x[rr][j].z), fabsf(x[rr][j].w))));
#pragma unroll
      for (int o = 32; o; o >>= 1) am = fmaxf(am, __shfl_xor(am, o));
      const float scale = am > 0.f ? 256.f / am : 1.f;
      u32x4 q;
#pragma unroll
      for (int j = 0; j < 4; ++j) {
        int w = __builtin_amdgcn_cvt_pk_fp8_f32(x[rr][j].x * scale, x[rr][j].y * scale, 0, false);
        w = __builtin_amdgcn_cvt_pk_fp8_f32(x[rr][j].z * scale, x[rr][j].w * scale, w, true);
        q[j] = (unsigned)w;
      }
      *(u32x4*)(dst + (size_t)rr * 2048) = q;
      if (lane == 0) sc[rr] = am > 0.f ? am * (1.f / 256.f) : 1.f;
    }
  }
}

DI void transpose_tile(const float* src, bf16_t* dst, int K, int N, int k0, int n0, float* tile  ) {
  const int tid = threadIdx.x;
#pragma unroll
  for (int i = 0; i < 4; ++i) {
    const int row = i * 16 + (tid >> 4), c4 = (tid & 15) * 4;
    const float4 v = ld_nt4(src + (size_t)(k0 + row) * N + n0 + c4);
    tile[row * 65 + c4] = v.x; tile[row * 65 + c4 + 1] = v.y; tile[row * 65 + c4 + 2] = v.z; tile[row * 65 + c4 + 3] = v.w;
  }
  __syncthreads();
#pragma unroll
  for (int i = 0; i < 2; ++i) {
    const int nrow = i * 32 + (tid >> 3), kc = (tid & 7) * 8;
    float f[8];
#pragma unroll
    for (int k = 0; k < 8; ++k) f[k] = tile[(kc + k) * 65 + nrow];
    *(uint4*)(dst + (size_t)(n0 + nrow) * K + k0 + kc) = pack8(f);
  }
  __syncthreads();
}

DI void phase0(const Params& p, char* smem) {
  const int tid = threadIdx.x;
  const int gthreads = gridDim.x * NTHR;
  const int gtid = blockIdx.x * NTHR + tid;
  char* ws = p.ws;
  for (int it = blockIdx.x; it < DEPTH * 1024; it += gridDim.x) {
    int l = it >> 10, r = it & 1023;
    if (r < 512) {
      int kt = r >> 5, nt = r & 31;
      transpose_tile(p.w_in + (size_t)l * DM * PC, (bf16_t*)(ws + OFF_WINT) + (size_t)l * PC * DM, DM, PC, kt * 64, nt * 64, (float*)smem);
    } else if (r < 768) {
      int q = r - 512, kt = q >> 4, nt = q & 15;
      transpose_tile(p.w_out + (size_t)l * DM * DM, (bf16_t*)(ws + OFF_WOUTT) + (size_t)l * DM * DM, DM, DM, kt * 64, nt * 64, (float*)smem);
    } else {
      int q = r - 768, kt = q >> 4, nt = q & 15;
      transpose_tile(p.peer_wq + (size_t)l * DM * DM, (bf16_t*)(ws + OFF_WQT) + (size_t)l * DM * DM, DM, DM, kt * 64, nt * 64, (float*)smem);
    }
  }
  {
    float* sv = (float*)smem;
    float* red = sv + 3 * 1024;
    for (int i = tid; i < 3 * 1024; i += NTHR) {
      int v = i >> 10, k = i & 1023;
      float x = (v == 0) ? p.c_ctx[k] : p.c[(v - 1) * 1024 + k];
      sv[i] = x / (1.f + __expf(-x));
    }
    __syncthreads();
    const int wave = tid >> 6, lane = tid & 63;
    float* modp = (float*)(ws + OFF_MODP);
    for (int it = blockIdx.x; it < DEPTH * 24 * 16; it += gridDim.x) {
      int l = it / 384, r = it % 384, nb = r >> 4, ks = r & 15;
      int kbase = ks * 64 + wave * 16;
      const float* wp = p.w_mod + ((size_t)l * DM + kbase) * 6144 + nb * 256 + lane * 4;
      float4 w[16];
#pragma unroll
      for (int k = 0; k < 16; ++k) w[k] = ld_nt4(wp + (size_t)k * 6144);
      float a[3][4];
#pragma unroll
      for (int v = 0; v < 3; ++v) { a[v][0] = a[v][1] = a[v][2] = a[v][3] = 0.f; }
#pragma unroll
      for (int k = 0; k < 16; ++k) {
#pragma unroll
        for (int v = 0; v < 3; ++v) {
          float s = sv[v * 1024 + kbase + k];
          a[v][0] += s * w[k].x; a[v][1] += s * w[k].y; a[v][2] += s * w[k].z; a[v][3] += s * w[k].w;
        }
      }
#pragma unroll
      for (int v = 0; v < 3; ++v)
        *(float4*)&red[(wave * 3 + v) * 256 + lane * 4] = make_float4(a[v][0], a[v][1], a[v][2], a[v][3]);
      __syncthreads();
      for (int i = tid; i < 768; i += NTHR) {
        int v = i >> 8, cidx = i & 255;
        float s = red[(0 * 3 + v) * 256 + cidx] + red[(1 * 3 + v) * 256 + cidx] + red[(2 * 3 + v) * 256 + cidx] + red[(3 * 3 + v) * 256 + cidx];
        modp[(((size_t)l * 16 + ks) * 3 + v) * 6144 + nb * 256 + cidx] = s;
      }
      __syncthreads();
    }
  }
  convert_tables(p, 0, (SPLIT_OFFSET ? 3 : 4) * NEXP, blockIdx.x * 4 + (tid >> 6), gridDim.x * 4);
  {
    const int n1 = 2 * 4 * 256 * 128 / 8, n2 = 2 * 4 * 256 * 256 / 8;
    for (int i = gtid; i < 2 * n1 + 2 * n2; i += gthreads) {
      const float* src; uint4* dst; int j;
      if (i < n1) { src = p.cwk; dst = (uint4*)(ws + OFF_CWKB); j = i; }
      else if (i < 2 * n1) { src = p.cwv; dst = (uint4*)(ws + OFF_CWVB); j = i - n1; }
      else if (i < 2 * n1 + n2) { src = p.cdk; dst = (uint4*)(ws + OFF_CDKB); j = i - 2 * n1; }
      else { src = p.cdv; dst = (uint4*)(ws + OFF_CDVB); j = i - 2 * n1 - n2; }
      float4 a = ((const float4*)src)[2 * j], bb = ((const float4*)src)[2 * j + 1];
      uint4 rr; rr.x = pk2(a.x, a.y); rr.y = pk2(a.z, a.w); rr.z = pk2(bb.x, bb.y); rr.w = pk2(bb.z, bb.w);
      dst[j] = rr;
    }
  }
  for (int i = gtid; i < DEPTH * 2 * 128 * 64 / 8; i += gthreads) {
    float4 a = ((const float4*)p.peer_keys)[2 * i], bb = ((const float4*)p.peer_keys)[2 * i + 1];
    uint4 rr; rr.x = pk2(a.x, a.y); rr.y = pk2(a.z, a.w); rr.z = pk2(bb.x, bb.y); rr.w = pk2(bb.z, bb.w);
    ((uint4*)(ws + OFF_KEYB))[i] = rr;
  }
  {
    float* rb = (float*)(ws + OFF_ROPEB);
    float* rc = (float*)(ws + OFF_ROPEC);
    for (int i = gtid; i < 1024 * 64; i += gthreads) {
      int pos = i >> 6, d = i & 63;
      float pv = (d < 32) ? (float)(pos >> 6) : (float)(pos & 63);
      float inv = powf(10000.f, -(float)(d & 15) / 16.f);
      float ang = pv * inv;
      rb[i] = cosf(ang);
      rb[1024 * 64 + i] = sinf(ang);
    }
    for (int i = gtid; i < 1024 * 32; i += gthreads) {
      int pos = i >> 5, d = i & 31;
      float pv = (d < 16) ? (float)(pos >> 6) : (float)(pos & 63);
      float inv = powf(10000.f, -(float)(d & 7) / 8.f);
      float ang = pv * inv;
      rc[i] = cosf(ang);
      rc[1024 * 32 + i] = sinf(ang);
    }
  }
  if (blockIdx.x == 0) { for (int i = tid; i < 2 * 32 * 512; i += NTHR) ((int*)(ws + OFF_QCTR))[i] = 0; }
  if (blockIdx.x == 0 && tid < DEPTH) {
    int l = tid;
    float s0 = 0.f, s1 = 0.f;
    for (int i = 0; i < 32; ++i) {
      s0 += p.lam_q[l * 64 + i] * p.lam_k[l * 64 + i];
      s1 += p.lam_q[l * 64 + 32 + i] * p.lam_k[l * 64 + 32 + i];
    }
    float lam_init = 0.8f - 0.6f * expf(-0.3f * (float)l);
    ((float*)(ws + OFF_LAM))[l] = expf(s0) - expf(s1) + lam_init;
    ((float*)(ws + OFF_LAM))[4 + l] = lam_init;
  }
}

DI void phase_modreduce(const Params& p) {
  const int gthreads = gridDim.x * NTHR;
  const int gtid = blockIdx.x * NTHR + threadIdx.x;
  const float* modp = (const float*)(p.ws + OFF_MODP);
  float* mod = (float*)(p.ws + OFF_MOD);
  for (int i = gtid; i < DEPTH * 3 * 6144; i += gthreads) {
    int l = i / (3 * 6144), r = i % (3 * 6144), n = r % 6144;
    float s = p.b_mod[l * 6144 + n];
#pragma unroll
    for (int ks = 0; ks < 16; ++ks) s += modp[((size_t)l * 16 + ks) * 3 * 6144 + r];
    mod[i] = s;
  }
}

DI void phase_ln0(const Params& p) {
  const int lane = threadIdx.x & 63;
  const int gw = blockIdx.x * 4 + (threadIdx.x >> 6), nw = gridDim.x * 4;
  float* X = (float*)(p.ws + OFF_X);
  bf16_t* H = (bf16_t*)(p.ws + OFF_H);
  const float* mod = (const float*)(p.ws + OFF_MOD);
  for (int t = gw; t < NT; t += nw) {
    const float* src = t < TCTX ? p.x_prompt + (size_t)t * DM : p.x_sample + (size_t)(t - TCTX) * DM;
    float v[16];
#pragma unroll
    for (int c = 0; c < 2; ++c) {
      const float4 a = ld_nt4(src + c * 512 + lane * 8), bq = ld_nt4(src + c * 512 + lane * 8 + 4);
      v[c * 8 + 0] = a.x; v[c * 8 + 1] = a.y; v[c * 8 + 2] = a.z; v[c * 8 + 3] = a.w;
      v[c * 8 + 4] = bq.x; v[c * 8 + 5] = bq.y; v[c * 8 + 6] = bq.z; v[c * 8 + 7] = bq.w;
    }
    store_row(X + (size_t)t * DM, lane, v);
    ln_mod_to_bf(v, mod + (size_t)(0 * 3 + tok_grp(t)) * 6144, 0, H + (size_t)t * DM, lane);
  }
}

DI void phase_ln1(const Grp& gr, const Params& p, int l, bool dry) {
  const int tid = opaque_tid();
  const int lane = tid & 63;
  const int gw = gr.lq * 4 + (tid >> 6), nw = gr.QB * 4;
  const float* X = (const float*)(p.ws + OFF_X);
  float* Xo = (float*)(p.ws + (dry ? OFF_X2 : OFF_X));
  bf16_t* H = (bf16_t*)(p.ws + (dry ? OFF_H2 : OFF_H));
  const float* mod = (const float*)(p.ws + OFF_MOD);
  for (int uq = gw; uq < QTOK; uq += nw) {
    const int t = tok_g(gr.g, gr.j * QTOK + uq);
    float v[16], g[16], b[16];
    load_row(X + (size_t)t * DM, lane, v);
    load_row(p.ln_g + (size_t)(l * 2 + 0) * DM, lane, g);
    load_row(p.ln_b + (size_t)(l * 2 + 0) * DM, lane, b);
    float mu, rstd;
    ln_stats(v, mu, rstd);
#pragma unroll
    for (int i = 0; i < 16; ++i) v[i] = (v[i] - mu) * rstd * g[i] + b[i];
    store_row(Xo + (size_t)t * DM, lane, v);
    ln_mod_to_bf(v, mod + (size_t)(l * 3 + tok_grp(t)) * 6144, 3072, H + (size_t)t * DM, lane);
  }
}

constexpr int GSTR = 72;
template <class Epi>
DI void gemm_phase(const Grp& gr, int nshard, const bf16_t* __restrict__ A, const bf16_t* __restrict__ Bt, int N, char* smem, int* ctr, Epi epi) {
  const int tid = opaque_tid(), lane = tid & 63, wave = tid >> 6;
  const int r = lane & 31, h = lane >> 5;
  const int wm = wave >> 1, wn = wave & 1;
  bf16_t* As = (bf16_t*)smem;
  bf16_t* Bs = As + 2 * 128 * GSTR;
  const int tiles_n = N >> 7;
  const int ntiles = 6 * tiles_n;
  bool qfirst = true;
  for (;;) {
    const int tile = next_tile_q(gr, ctr + gr.j * 64, smem, qfirst);
    if (tile >= ntiles) break;
    const int tn = tile % tiles_n, tm = mtile_g(gr.g, gr.j * 6 + tile / tiles_n);
    const int m0 = tm * 128, n0 = tn * 128;
    const bf16_t* Ap = A + (size_t)m0 * DM;
    const bf16_t* Bp = Bt + (size_t)n0 * DM;
    f32x16 acc[2][2];
#pragma unroll
    for (int i = 0; i < 2; ++i)
#pragma unroll
      for (int j = 0; j < 2; ++j)
#pragma unroll
        for (int e = 0; e < 16; ++e) acc[i][j][e] = 0.f;
    u32x4 ra0[4], rb0[4], ra1[4], rb1[4];
    const bf16_t* Ag = Ap + (size_t)(tid >> 3) * DM + (tid & 7) * 8;
    const bf16_t* Bg = Bp + (size_t)(tid >> 3) * DM + (tid & 7) * 8;
    const int lofs = (tid >> 3) * GSTR + (tid & 7) * 8;
#define G_LOAD(RA, RB, KT) { _Pragma("unroll") for (int i = 0; i < 4; ++i) { \
      RA[i] = *(const u32x4*)(Ag + (size_t)i * 32 * DM + (KT) * 64); RB[i] = *(const u32x4*)(Bg + (size_t)i * 32 * DM + (KT) * 64); } }
#define G_STORE(RA, RB, BUF) { _Pragma("unroll") for (int i = 0; i < 4; ++i) { \
      *(u32x4*)(As + (BUF) * 128 * GSTR + lofs + i * 32 * GSTR) = RA[i]; *(u32x4*)(Bs + (BUF) * 128 * GSTR + lofs + i * 32 * GSTR) = RB[i]; } }
#define G_FRAGS(SET, Ac, Bc, KS) { \
        fa0[SET] = *(const bf16x8*)(Ac + (wm * 64 + r) * GSTR + (KS) * 16 + h * 8); \
        fa1[SET] = *(const bf16x8*)(Ac + (wm * 64 + 32 + r) * GSTR + (KS) * 16 + h * 8); \
        fb0[SET] = *(const bf16x8*)(Bc + (wn * 64 + r) * GSTR + (KS) * 16 + h * 8); \
        fb1[SET] = *(const bf16x8*)(Bc + (wn * 64 + 32 + r) * GSTR + (KS) * 16 + h * 8); }
#define G_MFMAS(SET) { \
        acc[0][0] = MFMA(fa0[SET], fb0[SET], acc[0][0]); acc[0][1] = MFMA(fa0[SET], fb1[SET], acc[0][1]); \
        acc[1][0] = MFMA(fa1[SET], fb0[SET], acc[1][0]); acc[1][1] = MFMA(fa1[SET], fb1[SET], acc[1][1]); }
#define G_COMPUTE(BUF) { const bf16_t* Ac = As + (BUF) * 128 * GSTR; const bf16_t* Bc = Bs + (BUF) * 128 * GSTR; \
      bf16x8 fa0[2], fa1[2], fb0[2], fb1[2]; \
      G_FRAGS(0, Ac, Bc, 0); \
      __builtin_amdgcn_sched_barrier(0); \
      G_FRAGS(1, Ac, Bc, 1); \
      __builtin_amdgcn_sched_barrier(0); \
      G_MFMAS(0); \
      __builtin_amdgcn_sched_barrier(0); \
      G_FRAGS(0, Ac, Bc, 2); \
      __builtin_amdgcn_sched_barrier(0); \
      G_MFMAS(1); \
      __builtin_amdgcn_sched_barrier(0); \
      G_FRAGS(1, Ac, Bc, 3); \
      __builtin_amdgcn_sched_barrier(0); \
      G_MFMAS(0); \
      __builtin_amdgcn_sched_barrier(0); \
      G_MFMAS(1); \
      __builtin_amdgcn_sched_barrier(0); }
    G_LOAD(ra0, rb0, 0);
    G_LOAD(ra1, rb1, 1);
    G_STORE(ra0, rb0, 0);
    __syncthreads();
#pragma unroll 1
    for (int kt = 0; kt < 16; kt += 2) {
      if (kt + 2 < 16) G_LOAD(ra0, rb0, kt + 2);
      G_COMPUTE(0);
      G_STORE(ra1, rb1, 1);
      __syncthreads();
      if (kt + 3 < 16) G_LOAD(ra1, rb1, kt + 3);
      G_COMPUTE(1);
      if (kt + 2 < 16) G_STORE(ra0, rb0, 0);
      __syncthreads();
    }
#undef G_LOAD
#undef G_STORE
#undef G_COMPUTE
#undef G_FRAGS
#undef G_MFMAS
#pragma unroll
    for (int i = 0; i < 2; ++i)
#pragma unroll
      for (int j = 0; j < 2; ++j) epi(m0 + wm * 64 + i * 32, n0 + wn * 64 + j * 32, acc[i][j], r, h);
  }
}

constexpr int KSTR = 72;
constexpr int VSTR = 136;

struct AttnState { f32x16 o[2]; float m, l; };

DI void stage_k_bf(bf16_t* Ks, const bf16_t* src) {
  int tid = threadIdx.x;
  asm volatile("" : "+v"(tid));
#pragma unroll
  for (int i = 0; i < 4; ++i) {
    int id = tid + 256 * i, row = id >> 3, ch = id & 7;
    *(uint4*)(Ks + row * KSTR + ch * 8) = *(const uint4*)(src + (size_t)row * PC + ch * 8);
  }
}
DI void stage_k_f32(bf16_t* Ks, const float* src, int rstride) {
  int tid = threadIdx.x;
  asm volatile("" : "+v"(tid));
#pragma unroll
  for (int i = 0; i < 4; ++i) {
    int id = tid + 256 * i, row = id >> 3, ch = id & 7;
    const float* s = src + (size_t)row * rstride + ch * 8;
    float4 a = *(const float4*)s, b = *(const float4*)(s + 4);
    uint4 r; r.x = pk2(a.x, a.y); r.y = pk2(a.z, a.w); r.z = pk2(b.x, b.y); r.w = pk2(b.z, b.w);
    *(uint4*)(Ks + row * KSTR + ch * 8) = r;
  }
}
DI void stage_vt_bf(bf16_t* Vt, const bf16_t* src) {
  int tid = threadIdx.x;
  asm volatile("" : "+v"(tid));
#pragma unroll
  for (int i = 0; i < 4; ++i) {
    int id = tid + 256 * i, row = id & 127, ch = id >> 7;
    uint4 v = *(const uint4*)(src + (size_t)row * PC + ch * 8);
    unsigned w[4] = {v.x, v.y, v.z, v.w};
#pragma unroll
    for (int k = 0; k < 4; ++k) {
      Vt[(ch * 8 + 2 * k) * VSTR + row] = (bf16_t)(w[k] & 0xffffu);
      Vt[(ch * 8 + 2 * k + 1) * VSTR + row] = (bf16_t)(w[k] >> 16);
    }
  }
}
DI void stage_vt_f32(bf16_t* Vt, const float* src, int rstride) {
  int tid = threadIdx.x;
  asm volatile("" : "+v"(tid));
#pragma unroll
  for (int i = 0; i < 4; ++i) {
    int id = tid + 256 * i, row = id & 127, ch = id >> 7;
    const float* s = src + (size_t)row * rstride + ch * 8;
    float4 a = *(const float4*)s, b = *(const float4*)(s + 4);
    float f[8] = {a.x, a.y, a.z, a.w, b.x, b.y, b.z, b.w};
#pragma unroll
    for (int k = 0; k < 8; ++k) Vt[(ch * 8 + k) * VSTR + row] = f2bf(f[k]);
  }
}

template <int NKS>
DI void attn_tile(const bf16_t* Ks, int kcol0, const bf16_t* Vt, const bf16x8 (&qf)[NKS], AttnState& st, float cscale,
                  int maskmode, int qpos, int kpos0, int r, int h) {
  f32x16 s[2];
#pragma unroll
  for (int kb = 0; kb < 2; ++kb) {
#pragma unroll
    for (int e = 0; e < 16; ++e) s[kb][e] = 0.f;
#pragma unroll
    for (int ks = 0; ks < NKS; ++ks) {
      bf16x8 a = *(const bf16x8*)(Ks + (kb * 32 + r) * KSTR + kcol0 + ks * 16 + h * 8);
      s[kb] = MFMA(a, qf[ks], s[kb]);
    }
  }
  float tmax = -INFINITY;
#pragma unroll
  for (int kb = 0; kb < 2; ++kb)
#pragma unroll
    for (int e = 0; e < 16; ++e) {
      float v = s[kb][e] * cscale;
      if (maskmode) {
        int kp = kpos0 + kb * 32 + crow(e, h);
        int dd = kp - qpos; dd = dd < 0 ? -dd : dd;
        v = (dd <= 128) ? v : -INFINITY;
      }
      s[kb][e] = v;
      tmax = fmaxf(tmax, v);
    }
  tmax = fmaxf(tmax, __shfl_xor(tmax, 32));
  float mnew = fmaxf(st.m, tmax);
  float alpha = (mnew == -INFINITY) ? 1.f : __builtin_amdgcn_exp2f(st.m - mnew);
  float msub = (mnew == -INFINITY) ? 0.f : mnew;
  float psum = 0.f;
#pragma unroll
  for (int kb = 0; kb < 2; ++kb)
#pragma unroll
    for (int e = 0; e < 16; ++e) {
      float pv = __builtin_amdgcn_exp2f(s[kb][e] - msub);
      s[kb][e] = pv;
      psum += pv;
    }
  st.l = st.l * alpha + psum;
  st.m = mnew;
#pragma unroll
  for (int db = 0; db < 2; ++db)
#pragma unroll
    for (int e = 0; e < 16; ++e) st.o[db][e] *= alpha;
#pragma unroll
  for (int kb = 0; kb < 2; ++kb)
#pragma unroll
    for (int ss = 0; ss < 2; ++ss) {
      uint4 pu;
      pu.x = pk2(s[kb][8 * ss + 0], s[kb][8 * ss + 1]);
      pu.y = pk2(s[kb][8 * ss + 2], s[kb][8 * ss + 3]);
      pu.z = pk2(s[kb][8 * ss + 4], s[kb][8 * ss + 5]);
      pu.w = pk2(s[kb][8 * ss + 6], s[kb][8 * ss + 7]);
      bf16x8 pb = as_bf16x8(pu);
#pragma unroll
      for (int db = 0; db < 2; ++db) {
        const bf16_t* vp = Vt + (db * 32 + r) * VSTR + kb * 32 + 16 * ss + 4 * h;
        s16x4 lo = *(const s16x4*)vp;
        s16x4 hi = *(const s16x4*)(vp + 8);
        bf16x8 va = __builtin_shufflevector(lo, hi, 0, 1, 2, 3, 4, 5, 6, 7);
        st.o[db] = MFMA(va, pb, st.o[db]);
      }
    }
}

DI void store_oT(bf16_t* O, int token, int colbase, const f32x16 (&o)[2], int h) {
#pragma unroll
  for (int db = 0; db < 2; ++db)
#pragma unroll
    for (int g = 0; g < 4; ++g) {
      uint2 u;
      u.x = pk2(o[db][4 * g + 0], o[db][4 * g + 1]);
      u.y = pk2(o[db][4 * g + 2], o[db][4 * g + 3]);
      *(uint2*)(O + (size_t)token * DM + colbase + db * 32 + 8 * g + 4 * h) = u;
    }
}

DI void attn_init(AttnState& st, float m0, float l0) {
#pragma unroll
  for (int db = 0; db < 2; ++db)
#pragma unroll
    for (int e = 0; e < 16; ++e) st.o[db][e] = 0.f;
  st.m = m0;
  st.l = l0;
}

DI void mixer_bc(const Params& p, int l, bool isC, bool lat, int b, int hd, int qb, char* smem) {
  const int tid = opaque_tid(), lane = tid & 63, wave = tid >> 6, r = lane & 31, h = lane >> 5;
  const int qblk = wave >> 1, role = wave & 1;
  const int hdw = isC ? hd : (hd & ~1) + role;
  bf16_t* Ks = (bf16_t*)smem;
  bf16_t* Vt = Ks + 128 * KSTR;
  float* xch = (float*)smem;
  const bf16_t* P = (const bf16_t*)(p.ws + OFF_P);
  const int kv = hd >> 1;
  const int seq0 = lat ? TCTX + b * 1024 : b * 256;
  const int qpos = qb * 64 + qblk * 32 + r;
  const int qtok = seq0 + qpos;
  const float LOG2E = 1.4426950408889634f;
  bf16x8 qf[4];
  {
    const int qcol = isC ? 1024 + hd * 64 + role * 32 : 512 + hdw * 64;
    const bf16_t* qp = P + (size_t)qtok * PC + qcol + h * 8;
    qf[0] = *(const bf16x8*)(qp);
    qf[1] = *(const bf16x8*)(qp + 16);
    qf[2] = qf[0]; qf[3] = qf[1];
    if (!isC) { qf[2] = *(const bf16x8*)(qp + 32); qf[3] = *(const bf16x8*)(qp + 48); }
  }
  const float cscale = isC ? 0.17677669529663687f * LOG2E : 0.125f * LOG2E;
  AttnState st;
  if (isC) attn_init(st, -INFINITY, 0.f);
  else attn_init(st, p.win_sink[l * 4 + hdw] * LOG2E, (h == 0) ? 1.f : 0.f);
  const int ntile = isC ? (lat ? 10 : 2) : (lat ? 5 : 2);
  const int band0 = (qb >> 1) - 1;
  u32x4 kreg[4], vreg[4];
  auto tile_exists = [&](int ti) -> bool {
    if (!isC && lat && ti < 3) { int kt = band0 + ti; return kt >= 0 && kt < 8; }
    return true;
  };
  auto tile_load = [&](int ti) {
    const bf16_t *kp, *vp; int stride;
    if (isC) {
      if (lat && ti < 2) {
        const size_t off = ((size_t)(b * DEPTH + l) * 256 + ti * 128) * 256 + hd * 64;
        kp = (const bf16_t*)(p.ws + OFF_CDKB) + off; vp = (const bf16_t*)(p.ws + OFF_CDVB) + off; stride = 256;
      } else {
        const int kt = lat ? ti - 2 : ti;
        const bf16_t* base = P + (size_t)(seq0 + kt * 128) * PC;
        kp = base + 1280 + hd * 64; vp = base + 1536 + hd * 64; stride = PC;
      }
    } else {
      if (lat && ti >= 3) {
        const size_t off = ((size_t)(b * DEPTH + l) * 256 + (ti - 3) * 128) * 128 + kv * 64;
        kp = (const bf16_t*)(p.ws + OFF_CWKB) + off; vp = (const bf16_t*)(p.ws + OFF_CWVB) + off; stride = 128;
      } else {
        const int kt = lat ? band0 + ti : ti;
        const bf16_t* base = P + (size_t)(seq0 + kt * 128) * PC;
        kp = base + 768 + kv * 64; vp = base + 896 + kv * 64; stride = PC;
      }
    }
    int t2 = tid;
    asm volatile("" : "+v"(t2));
#pragma unroll
    for (int i = 0; i < 4; ++i) {
      int id = t2 + 256 * i;
      kreg[i] = *(const u32x4*)(kp + (size_t)(id >> 3) * stride + (id & 7) * 8);
      vreg[i] = *(const u32x4*)(vp + (size_t)(id & 127) * stride + (id >> 7) * 8);
    }
  };
  auto tile_store = [&]() {
    int t2 = tid;
    asm volatile("" : "+v"(t2));
#pragma unroll
    for (int i = 0; i < 4; ++i) {
      int id = t2 + 256 * i;
      *(u32x4*)(Ks + (id >> 3) * KSTR + (id & 7) * 8) = kreg[i];
      const int row = id & 127, ch = id >> 7;
#pragma unroll
      for (int k = 0; k < 4; ++k) {
        Vt[(ch * 8 + 2 * k) * VSTR + row] = (bf16_t)(vreg[i][k] & 0xffffu);
        Vt[(ch * 8 + 2 * k + 1) * VSTR + row] = (bf16_t)(vreg[i][k] >> 16);
      }
    }
  };
  if (tile_exists(0)) tile_load(0);
#pragma unroll 1
  for (int ti = 0; ti < ntile; ++ti) {
    const bool ex = tile_exists(ti);
    __syncthreads();
    if (ex) tile_store();
    __syncthreads();
    if (ti + 1 < ntile && tile_exists(ti + 1)) tile_load(ti + 1);
    if (ex) {
      if (isC) {
        const bf16x8 q2[2] = {qf[0], qf[1]};
#pragma unroll 1
        for (int hf = 0; hf < 2; ++hf)
          attn_tile<2>(Ks + hf * 64 * KSTR, role * 32, Vt + hf * 64, q2, st, cscale, 0, 0, 0, r, h);
      } else {
        const bool band = lat && ti < 3;
#pragma unroll 1
        for (int hf = 0; hf < 2; ++hf)
          attn_tile<4>(Ks + hf * 64 * KSTR, 0, Vt + hf * 64, qf, st, cscale, band ? 1 : 0, qpos, (band0 + ti) * 128 + hf * 64, r, h);
      }
    }
  }
  if (!isC) {
    const float inv = 1.f / (st.l + __shfl_xor(st.l, 32));
#pragma unroll
    for (int db = 0; db < 2; ++db)
#pragma unroll
      for (int e = 0; e < 16; ++e) st.o[db][e] *= inv;
    store_oT((bf16_t*)(p.ws + OFF_O), qtok, 256 + hdw * 64, st.o, h);
    return;
  }
  __syncthreads();
  float* xp = xch + (size_t)(qblk * 64 + lane) * 36;
  if (role == 1) {
#pragma unroll
    for (int db = 0; db < 2; ++db)
#pragma unroll
      for (int g = 0; g < 4; ++g)
        *(float4*)(xp + db * 16 + g * 4) = make_float4(st.o[db][4 * g], st.o[db][4 * g + 1], st.o[db][4 * g + 2], st.o[db][4 * g + 3]);
    xp[32] = st.m; xp[33] = st.l;
  }
  __syncthreads();
  if (role == 0) {
    f32x16 o1[2];
#pragma unroll
    for (int db = 0; db < 2; ++db)
#pragma unroll
      for (int g = 0; g < 4; ++g) {
        float4 v = *(const float4*)(xp + db * 16 + g * 4);
        o1[db][4 * g] = v.x; o1[db][4 * g + 1] = v.y; o1[db][4 * g + 2] = v.z; o1[db][4 * g + 3] = v.w;
      }
    const float m1 = xp[32], l1 = xp[33];
    if (isC) {
      const float lam = ((const float*)(p.ws + OFF_LAM))[l];
      const float lam_init = ((const float*)(p.ws + OFF_LAM))[4 + l];
      float i0 = 1.f / (st.l + __shfl_xor(st.l, 32));
      float i1 = lam / (l1 + __shfl_xor(l1, 32));
      float ss = 0.f;
#pragma unroll
      for (int db = 0; db < 2; ++db)
#pragma unroll
        for (int e = 0; e < 16; ++e) {
          float w = st.o[db][e] * i0 - o1[db][e] * i1;
          st.o[db][e] = w;
          ss += w * w;
        }
      ss += __shfl_xor(ss, 32);
      float rs = rsqrtf(ss * (1.f / 64.f) + LN_EPS) * (1.f - lam_init);
#pragma unroll
      for (int db = 0; db < 2; ++db)
#pragma unroll
        for (int e = 0; e < 16; ++e) st.o[db][e] *= rs * p.subln_g[l * 64 + db * 32 + crow(e, h)];
      store_oT((bf16_t*)(p.ws + OFF_O), qtok, 512 + hd * 64, st.o, h);
    } else {
      const float m = fmaxf(st.m, m1);
      const float a0 = __builtin_amdgcn_exp2f(st.m - m), a1 = __builtin_amdgcn_exp2f(m1 - m);
      float lt = st.l * a0 + l1 * a1;
      lt += __shfl_xor(lt, 32);
      const float inv = 1.f / lt;
      const float c0 = a0 * inv, c1 = a1 * inv;
#pragma unroll
      for (int db = 0; db < 2; ++db)
#pragma unroll
        for (int e = 0; e < 16; ++e) st.o[db][e] = st.o[db][e] * c0 + o1[db][e] * c1;
      store_oT((bf16_t*)(p.ws + OFF_O), qtok, 256 + hd * 64, st.o, h);
    }
  }
}

DI void mixer_a(const Params& p, int l, int ch, int hd, char* smem) {
  const int tid = opaque_tid(), lane = tid & 63, wave = tid >> 6, r = lane & 31, h = lane >> 5;
  bf16_t* Vt = (bf16_t*)smem;
  const bf16_t* P = (const bf16_t*)(p.ws + OFF_P);
  const int tok0 = ch * 128;
  __syncthreads();
  stage_vt_bf(Vt, P + (size_t)tok0 * PC + 256 + hd * 64);
  __syncthreads();
  const int pp = wave * 32 + r;
  const float* wrow = p.chunk_w + ((size_t)(l * 4 + hd) * 128 + pp) * 128;
  f32x16 acc[2];
#pragma unroll
  for (int db = 0; db < 2; ++db)
#pragma unroll
    for (int e = 0; e < 16; ++e) acc[db][e] = 0.f;
#pragma unroll
  for (int ks = 0; ks < 8; ++ks) {
    float4 a = *(const float4*)(wrow + ks * 16 + 8 * h), b = *(const float4*)(wrow + ks * 16 + 8 * h + 4);
    uint4 wu; wu.x = pk2(a.x, a.y); wu.y = pk2(a.z, a.w); wu.z = pk2(b.x, b.y); wu.w = pk2(b.z, b.w);
    bf16x8 wb = as_bf16x8(wu);
#pragma unroll
    for (int db = 0; db < 2; ++db) {
      bf16x8 va = *(const bf16x8*)(Vt + (db * 32 + r) * VSTR + ks * 16 + 8 * h);
      acc[db] = MFMA(va, wb, acc[db]);
    }
  }
  const float bias = p.chunk_b[(l * 4 + hd) * 128 + pp];
  const int token = tok0 + pp;
#pragma unroll
  for (int db = 0; db < 2; ++db)
#pragma unroll
    for (int g = 0; g < 4; ++g) {
      uint2 uu = *(const uint2*)(P + (size_t)token * PC + hd * 64 + db * 32 + 8 * g + 4 * h);
      acc[db][4 * g + 0] = bflo(uu.x) * (acc[db][4 * g + 0] + bias);
      acc[db][4 * g + 1] = bfhi(uu.x) * (acc[db][4 * g + 1] + bias);
      acc[db][4 * g + 2] = bflo(uu.y) * (acc[db][4 * g + 2] + bias);
      acc[db][4 * g + 3] = bfhi(uu.y) * (acc[db][4 * g + 3] + bias);
    }
  store_oT((bf16_t*)(p.ws + OFF_O), token, hd * 64, acc, h);
}

DI void mixer_d(const Params& p, int l, int ch, int g) {
  const int tid = opaque_tid(), lane = tid & 63, wave = tid >> 6, r = lane & 31, h = lane >> 5;
  const bf16_t* P = (const bf16_t*)(p.ws + OFF_P);
  const int token = ch * 128 + wave * 32 + r;
  int s0, slen;
  if (token < TCTX) { s0 = token & ~255; slen = 256; } else { s0 = TCTX + ((token - TCTX) & ~1023); slen = 1024; }
  const int pos = token - s0;
  const int w = 2 << g, hw = w >> 1;
  int lo = pos - hw; if (lo < 0) lo = 0;
  int hi = pos + hw; if (hi > slen) hi = slen;
  const float icnt = 1.f / (float)(hi - lo);
  const float* wp = p.pool_w + (size_t)(l * 4 + g) * 64 * 64;
  f32x16 acc[2];
#pragma unroll
  for (int db = 0; db < 2; ++db)
#pragma unroll
    for (int e = 0; e < 16; ++e) acc[db][e] = 0.f;
#pragma unroll
  for (int ks = 0; ks < 4; ++ks) {
    const int cbase = 1792 + g * 64 + ks * 16 + 8 * h;
    float sum[8];
#pragma unroll
    for (int k = 0; k < 8; ++k) sum[k] = 0.f;
    for (int i = 0; i < w; ++i) {
      int tt = pos - hw + i;
      if (tt >= 0 && tt < slen) {
        uint4 v = *(const uint4*)(P + (size_t)(s0 + tt) * PC + cbase);
        sum[0] += bflo(v.x); sum[1] += bfhi(v.x); sum[2] += bflo(v.y); sum[3] += bfhi(v.y);
        sum[4] += bflo(v.z); sum[5] += bfhi(v.z); sum[6] += bflo(v.w); sum[7] += bfhi(v.w);
      }
    }
    uint4 zv = *(const uint4*)(P + (size_t)token * PC + cbase);
    float z[8] = {bflo(zv.x), bfhi(zv.x), bflo(zv.y), bfhi(zv.y), bflo(zv.z), bfhi(zv.z), bflo(zv.w), bfhi(zv.w)};
    float pl[8];
#pragma unroll
    for (int k = 0; k < 8; ++k) pl[k] = sum[k] * icnt - z[k];
    bf16x8 pb = as_bf16x8(pack8(pl));
#pragma unroll
    for (int db = 0; db < 2; ++db) {
      float wv[8];
#pragma unroll
      for (int k = 0; k < 8; ++k) wv[k] = wp[(ks * 16 + 8 * h + k) * 64 + db * 32 + r];
      bf16x8 wa = as_bf16x8(pack8(wv));
      acc[db] = MFMA(wa, pb, acc[db]);
    }
  }
#pragma unroll
  for (int db = 0; db < 2; ++db)
#pragma unroll
    for (int e = 0; e < 16; ++e) acc[db][e] *= p.pool_scale[l * 256 + g * 64 + db * 32 + crow(e, h)];
  store_oT((bf16_t*)(p.ws + OFF_O), token, 768 + g * 64, acc, h);
}

DI void phase_mixers(const Grp& gr, int nshard, const Params& p, int l, char* smem, int* ctr) {
  bool qfirst = true;
  for (;;) {
    const int it = next_item(gr, ctr, smem, qfirst, nshard);
    if (it >= 480) break;
    if (it < 288) {
      bool lat, cmix; int b, hd, qb;
      if (it < 64) { int q = it; lat = true; cmix = true; b = gr.g; hd = (q >> 4) & 3; qb = q & 15; }
      else if (it < 96) { int q = it - 64; lat = true; cmix = false; b = gr.g; hd = ((q >> 4) & 1) * 2; qb = q & 15; }
      else if (it < 224) { int q = it - 96; lat = false; cmix = true; b = gr.g * 8 + (q >> 4); hd = (q >> 2) & 3; qb = q & 3; }
      else { int q = it - 224; lat = false; cmix = false; b = gr.g * 8 + (q >> 3); hd = ((q >> 2) & 1) * 2; qb = q & 3; }
      mixer_bc(p, l, cmix, lat, b, hd, qb, smem);
    } else if (it < 384) { int q = it - 288; mixer_a(p, l, mtile_g(gr.g, q >> 2), q & 3, smem); }
    else { int q = it - 384; mixer_d(p, l, mtile_g(gr.g, q >> 2), q & 3); }
  }
}

constexpr int PKSTR = 68;
constexpr int PKJ = 128 * PKSTR + 16;

typedef float f32x4 __attribute__((ext_vector_type(4)));
DI void phase_peer(const Grp& gr, const Params& p, int l, char* smem, bool dry) {
  const int tid = opaque_tid(), lane = tid & 63, wave = tid >> 6;
  unsigned* scr3 = (unsigned*)smem + wave * 1024;
  unsigned* eidx = scr3 + 768;
  float* egate = (float*)(scr3 + 896);
  __syncthreads();
  int ci = 0, cj = 0;
  {
    int L = lane, i = 0;
    while (i < 16 && L >= 16 / (i + 1)) { L -= 16 / (i + 1); ++i; }
    ci = i; cj = L;
  }
  const bool cvalid = lane < 50;
  if (!cvalid) { ci = 0; cj = 0; }
  const float* X = (const float*)(p.ws + OFF_X);
  float* Xw = (float*)(p.ws + (dry ? OFF_X2 : OFF_X));
  const bf16_t* Qb = (const bf16_t*)(p.ws + OFF_Q);
  const bf16_t* KB = (const bf16_t*)(p.ws + OFF_KEYB) + (size_t)l * 2 * 128 * 64;
  const bf16_t* H = (const bf16_t*)(p.ws + OFF_H);
  bf16_t* Hw = (bf16_t*)(p.ws + (dry ? OFF_H2 : OFF_H));
  float* Yw = dry ? (float*)(p.ws + OFF_X2) : p.out + OUT_Y;
  const float* mod = (const float*)(p.ws + OFF_MOD);
  const unsigned char* U8 = (const unsigned char*)(p.ws + OFF_UB) + (size_t)l * NEXP * 2048;
  const unsigned char* V8 = U8 + 1024;
  const float* USC = (const float*)(p.ws + OFF_USC) + (size_t)l * NEXP;
  const float* VSC = (const float*)(p.ws + OFF_VSC) + (size_t)l * NEXP;
  const int gw = gr.lq * 4 + wave, nw = gr.QB * 4;
  const int q0 = gr.j * QTOK;
#pragma unroll 1
  for (int tb = gw; tb < QTOK; tb += 3 * nw) {
    {
      const int c16 = lane & 15, quad = lane >> 4;
#pragma unroll 1
      for (int jc = 0; jc < 4; ++jc) {
        const int j = jc >> 1, c = (jc & 1) * 16 + c16;
        int ti = c >> 3; if (ti > 2) ti = 2;
        const int hh = c & 7;
        int tok = tb + ti * nw; if (tok >= QTOK) tok = tb;
        tok = tok_g(gr.g, q0 + tok);
        const bf16_t* qp = Qb + (size_t)tok * DM + hh * 128 + j * 64 + quad * 8;
        const bf16x8 b0 = *(const bf16x8*)qp, b1 = *(const bf16x8*)(qp + 32);
        const bf16_t* kp = KB + (size_t)(j * 128 + c16) * 64 + quad * 8;
        float top[16];
#pragma unroll
        for (int s = 0; s < 16; ++s) top[s] = -3.0e38f;
#pragma unroll
        for (int nb = 0; nb < 8; ++nb) {
          const bf16x8 a0 = *(const bf16x8*)(kp + nb * 16 * 64), a1 = *(const bf16x8*)(kp + nb * 16 * 64 + 32);
          f32x4 acc = {0.f, 0.f, 0.f, 0.f};
          acc = __builtin_amdgcn_mfma_f32_16x16x32_bf16(a0, b0, acc, 0, 0, 0);
          acc = __builtin_amdgcn_mfma_f32_16x16x32_bf16(a1, b1, acc, 0, 0, 0);
#pragma unroll
          for (int e = 0; e < 4; ++e) {
            float v = __uint_as_float((__float_as_uint(acc[e]) & ~0x7Fu) | (unsigned)(nb * 16 + quad * 4 + e));
#pragma unroll
            for (int s = 0; s < 16; ++s) {
              float hi_ = fmaxf(top[s], v);
              v = fminf(top[s], v);
              top[s] = hi_;
            }
          }
        }
#pragma unroll
        for (int step = 16; step <= 32; step <<= 1) {
          float oth[16];
#pragma unroll
          for (int s = 0; s < 16; ++s) oth[s] = __shfl_xor(top[s], step);
#pragma unroll
          for (int s = 0; s < 16; ++s) top[s] = fmaxf(top[s], oth[15 - s]);
#pragma unroll
          for (int dist = 8; dist >= 1; dist >>= 1) {
#pragma unroll
            for (int s = 0; s < 16; ++s) {
              if ((s & dist) == 0) {
                float a = top[s], b = top[s + dist];
                top[s] = fmaxf(a, b);
                top[s + dist] = fminf(a, b);
              }
            }
          }
        }
        if (quad == 0 && c < 24) {
          unsigned* dstp = scr3 + ((c >> 3) * 16 + 2 * hh + j) * 16;
#pragma unroll
          for (int s4 = 0; s4 < 4; ++s4)
            *(uint4*)(dstp + s4 * 4) = make_uint4(__float_as_uint(top[s4 * 4 + 0]), __float_as_uint(top[s4 * 4 + 1]),
                                                  __float_as_uint(top[s4 * 4 + 2]), __float_as_uint(top[s4 * 4 + 3]));
        }
      }
    }
    __builtin_amdgcn_fence(__ATOMIC_RELEASE, "wavefront");
    __builtin_amdgcn_wave_barrier();
    __builtin_amdgcn_fence(__ATOMIC_ACQUIRE, "wavefront");
#pragma unroll 1
    for (int ti3 = 0; ti3 < 3; ++ti3) {
    if (tb + ti3 * nw >= QTOK) break;
    const int t = tok_g(gr.g, q0 + tb + ti3 * nw);
    unsigned* scr = scr3 + ti3 * 256;
    for (int hd = 0; hd < 8; ++hd) {
      unsigned ka = scr[(2 * hd) * 16 + ci], kb = scr[(2 * hd + 1) * 16 + cj];
      float cand = cvalid ? (__uint_as_float(ka & ~0x7Fu) + __uint_as_float(kb & ~0x7Fu)) : -3.0e38f;
      int rank = 0;
#pragma unroll
      for (int m = 0; m < 50; ++m) {
        float sv = __uint_as_float(__builtin_amdgcn_readlane(__float_as_uint(cand), m));
        rank += (sv > cand) ? 1 : 0;
      }
      bool sel = cvalid && rank < 16;
      unsigned long long bm = __ballot(sel);
      int slot = __builtin_amdgcn_mbcnt_hi((unsigned)(bm >> 32), __builtin_amdgcn_mbcnt_lo((unsigned)bm, 0));
      unsigned long long b0 = __ballot(cvalid && rank == 0);
      int l0 = __ffsll((long long)b0) - 1;
      float mx = __uint_as_float(__builtin_amdgcn_readlane(__float_as_uint(cand), l0));
      float e = sel ? __expf(cand - mx) : 0.f;
      float sum = wave_sum(e);
      if (sel && slot < 16) {
        eidx[hd * 16 + slot] = (ka & 0x7Fu) * 128u + (kb & 0x7Fu);
        egate[hd * 16 + slot] = e / sum;
      }
    }
    __builtin_amdgcn_fence(__ATOMIC_RELEASE, "wavefront");
    __builtin_amdgcn_wave_barrier();
    __builtin_amdgcn_fence(__ATOMIC_ACQUIRE, "wavefront");
    const float* modv = mod + (size_t)(l * 3 + tok_grp(t)) * 6144;
    f2v_t h2[8], outp[8];
    {
#pragma unroll
      for (int j = 0; j < 4; ++j) {
        const uint2 hu = *(const uint2*)(H + (size_t)t * DM + j * 256 + lane * 4);
        h2[2 * j] = f2v_t{bflo(hu.x), bfhi(hu.x)};
        h2[2 * j + 1] = f2v_t{bflo(hu.y), bfhi(hu.y)};
      }
#pragma unroll
      for (int w = 0; w < 8; ++w) outp[w] = f2v_t{0.f, 0.f};
    }
    {
      float* eus = (float*)scr;
#pragma unroll
      for (int j = 0; j < 2; ++j) {
        const int i = lane + 64 * j;
        const unsigned id = eidx[i];
        eus[i] = USC[id];
        eus[128 + i] = egate[i] * VSC[id];
      }
    }
    __builtin_amdgcn_fence(__ATOMIC_RELEASE, "wavefront");
    __builtin_amdgcn_wave_barrier();
    __builtin_amdgcn_fence(__ATOMIC_ACQUIRE, "wavefront");
    const float* eus = (const float*)scr;
    u32x4 ub[16], vb[16];
#pragma unroll 1
    for (int hd = 0; hd < 8; ++hd) {
#pragma unroll
      for (int k = 0; k < 16; ++k) {
        unsigned id = __builtin_amdgcn_readfirstlane(eidx[hd * 16 + k]);
        ub[k] = *(const u32x4*)(U8 + ((size_t)id << 11) + lane * 16);
      }
#pragma unroll
      for (int k = 0; k < 16; ++k) {
        unsigned id = __builtin_amdgcn_readfirstlane(eidx[hd * 16 + k]);
        vb[k] = *(const u32x4*)(V8 + ((size_t)id << 11) + lane * 16);
      }
      float pd[16];
#pragma unroll
      for (int k = 0; k < 16; ++k) {
        f2v_t acc = {0.f, 0.f};
#pragma unroll
        for (int w = 0; w < 4; ++w) {
          acc = __builtin_elementwise_fma(__builtin_amdgcn_cvt_pk_f32_fp8((int)ub[k][w], false), h2[2 * w], acc);
          acc = __builtin_elementwise_fma(__builtin_amdgcn_cvt_pk_f32_fp8((int)ub[k][w], true), h2[2 * w + 1], acc);
        }
        pd[k] = acc.x + acc.y;
      }
      const bool b0 = lane & 1, b1 = lane & 2, b2 = lane & 4, b3 = lane & 8;
      float w8[8], w4[4], w2[2], z;
#pragma unroll
      for (int i = 0; i < 8; ++i) { float snd = b0 ? pd[i] : pd[8 + i], kp = b0 ? pd[8 + i] : pd[i]; w8[i] = kp + __shfl_xor(snd, 1); }
#pragma unroll
      for (int i = 0; i < 4; ++i) { float snd = b1 ? w8[i] : w8[4 + i], kp = b1 ? w8[4 + i] : w8[i]; w4[i] = kp + __shfl_xor(snd, 2); }
#pragma unroll
      for (int i = 0; i < 2; ++i) { float snd = b2 ? w4[i] : w4[2 + i], kp = b2 ? w4[2 + i] : w4[i]; w2[i] = kp + __shfl_xor(snd, 4); }
      { float snd = b3 ? w2[0] : w2[1], kp = b3 ? w2[1] : w2[0]; z = kp + __shfl_xor(snd, 8); }
      z += __shfl_xor(z, 16); z += __shfl_xor(z, 32);
      const int kmine = ((lane & 1) << 3) | ((lane & 2) << 1) | ((lane & 4) >> 1) | ((lane & 8) >> 3);
      const float cfl = eus[128 + hd * 16 + kmine] * gelu_t(z * eus[hd * 16 + kmine]);
#pragma unroll
      for (int k = 0; k < 16; ++k) {
        const int src = ((k >> 3) & 1) | (((k >> 2) & 1) << 1) | (((k >> 1) & 1) << 2) | ((k & 1) << 3);
        const float cf = __uint_as_float(__builtin_amdgcn_readlane(__float_as_uint(cfl), src));
        const f2v_t c2 = {cf, cf};
#pragma unroll
        for (int w = 0; w < 4; ++w) {
          outp[2 * w] = __builtin_elementwise_fma(__builtin_amdgcn_cvt_pk_f32_fp8((int)vb[k][w], false), c2, outp[2 * w]);
          outp[2 * w + 1] = __builtin_elementwise_fma(__builtin_amdgcn_cvt_pk_f32_fp8((int)vb[k][w], true), c2, outp[2 * w + 1]);
        }
      }
    }
    float x1[16], outv[16];
#pragma unroll
    for (int w = 0; w < 8; ++w) { outv[2 * w] = outp[w].x; outv[2 * w + 1] = outp[w].y; }
    load_row16(X + (size_t)t * DM, lane, x1);
    {
      float g2[16], g[16], bb[16];
      load_row16(modv + 5120, lane, g2);
      load_row16(p.ln_g + (size_t)(l * 2 + 1) * DM, lane, g);
      load_row16(p.ln_b + (size_t)(l * 2 + 1) * DM, lane, bb);
#pragma unroll
      for (int i = 0; i < 16; ++i) x1[i] = ALPHA * x1[i] + g2[i] * outv[i];
      float mu, rstd;
      ln_stats(x1, mu, rstd);
#pragma unroll
      for (int i = 0; i < 16; ++i) x1[i] = (x1[i] - mu) * rstd * g[i] + bb[i];
      if (l == DEPTH - 1) {
        {
          typedef float f32x4s __attribute__((ext_vector_type(4)));
#pragma unroll
          for (int j = 0; j < 4; ++j) {
            const f32x4s tv = {x1[4 * j], x1[4 * j + 1], x1[4 * j + 2], x1[4 * j + 3]};
            __builtin_nontemporal_store(tv, (f32x4s*)(Yw + (size_t)t * DM + j * 256 + lane * 4));
          }
        }
      } else {
        store_row16(Xw + (size_t)t * DM, lane, x1);
        const float* modn = mod + (size_t)((l + 1) * 3 + tok_grp(t)) * 6144;
        ln_stats(x1, mu, rstd);
        float sh[16], scv[16];
        load_row16(modn, lane, sh);
        load_row16(modn + 1024, lane, scv);
#pragma unroll
        for (int i = 0; i < 16; ++i) x1[i] = (x1[i] - mu) * rstd * (1.f + scv[i]) + sh[i];
#pragma unroll
        for (int j = 0; j < 4; ++j) {
          uint2 hu; hu.x = pk2(x1[4 * j], x1[4 * j + 1]); hu.y = pk2(x1[4 * j + 2], x1[4 * j + 3]);
          *(uint2*)(Hw + (size_t)t * DM + j * 256 + lane * 4) = hu;
        }
      }
    }
    }
  }
}

struct EpiG1 {
  const Params* p; int l;
  DI void operator()(int rb, int cb, const f32x16& acc, int r, int h) const {
    bf16_t* P = (bf16_t*)(p->ws + OFF_P);
    const int col = cb + r;
    const bool lat = rb >= TCTX;
    float v[16];
#pragma unroll
    for (int e = 0; e < 16; ++e) v[e] = acc[e];
    if (cb < 512) {
#pragma unroll
      for (int e = 0; e < 16; ++e) v[e] = gelu_t(v[e]);
    } else if (lat) {
      const bool ropeB = (cb < 896);
      const bool ropeC = (cb >= 1024 && cb < 1536);
      if (ropeB || ropeC) {
        const int dim = ropeB ? 64 : 32, q = ropeB ? 16 : 8;
        const float* tab = (const float*)(p->ws + (ropeB ? OFF_ROPEB : OFF_ROPEC));
        const int di = col & (dim - 1);
        const bool up = (di & q) != 0;
#pragma unroll
        for (int e = 0; e < 16; ++e) {
          int pos = (rb + crow(e, h) - TCTX) & 1023;
          float partner = __shfl_xor(v[e], q);
          float cs = tab[pos * dim + di], sn = tab[1024 * dim + pos * dim + di];
          v[e] = v[e] * cs + (up ? partner : -partner) * sn;
        }
      }
    }
#pragma unroll
    for (int e = 0; e < 16; ++e) {
      if (cb < 768 || (cb >= 1024 && cb < 1280)) __builtin_nontemporal_store(f2bf(v[e]), &P[(size_t)(rb + crow(e, h)) * PC + col]);
      else P[(size_t)(rb + crow(e, h)) * PC + col] = f2bf(v[e]);
    }
    if (!lat) {
      float* dst = nullptr; int width = 0, c0 = 0;
      if (cb >= 768 && cb < 896) { dst = p->out + OUT_WK; width = 128; c0 = 768; }
      else if (cb >= 896 && cb < 1024) { dst = p->out + OUT_WV; width = 128; c0 = 896; }
      else if (cb >= 1280 && cb < 1536) { dst = p->out + OUT_DK; width = 256; c0 = 1280; }
      else if (cb >= 1536 && cb < 1792) { dst = p->out + OUT_DV; width = 256; c0 = 1536; }
      if (dst) {
#pragma unroll
        for (int e = 0; e < 16; ++e) {
          int t = rb + crow(e, h), b = t >> 8, s = t & 255;
          __builtin_nontemporal_store(v[e], &dst[((size_t)(b * DEPTH + l) * 256 + s) * width + (col - c0)]);
        }
      }
    }
  }
};
struct EpiG2 {
  const Params* p; int l; bool dry;
  DI void operator()(int rb, int cb, const f32x16& acc, int r, int h) const {
    const float* X = (const float*)(p->ws + OFF_X);
    float* Xo = (float*)(p->ws + (dry ? OFF_X2 : OFF_X));
    const int col = cb + r;
    const float g1 = ((const float*)(p->ws + OFF_MOD))[(size_t)(l * 3 + tok_grp(rb)) * 6144 + 2048 + col];
#pragma unroll
    for (int e = 0; e < 16; ++e) {
      size_t idx = (size_t)(rb + crow(e, h)) * DM + col;
      Xo[idx] = ALPHA * X[idx] + g1 * acc[e];
    }
  }
};
struct EpiG3 {
  const Params* p;
  DI void operator()(int rb, int cb, const f32x16& acc, int r, int h) const {
    bf16_t* Q = (bf16_t*)(p->ws + OFF_Q);
    const int col = cb + r;
#pragma unroll
    for (int e = 0; e < 16; ++e) Q[(size_t)(rb + crow(e, h)) * DM + col] = f2bf(acc[e]);
  }
};

#define XB_TMO      128
#define XB_XCNT(j)  (256  + 64 * (j))
#define XB_XSUB(j)  (1280 + 64 * (j))
#define XB_XGEN(j)  (2304 + 64 * (j))
#define XB_TOP      3328
#define XB_TOPGEN   3392
#define XCD_BAR_WORDS 3456
#define XB_SPIN_CAP (1u << 18)
#define LAS __attribute__((address_space(3)))
DI unsigned xb_ld(unsigned* p) { return __hip_atomic_load(p, __ATOMIC_RELAXED, __HIP_MEMORY_SCOPE_AGENT); }
DI unsigned xb_add(unsigned* p, unsigned v) { return __hip_atomic_fetch_add(p, v, __ATOMIC_RELAXED, __HIP_MEMORY_SCOPE_AGENT); }
DI unsigned xb_xcc_id() { return (unsigned)__builtin_amdgcn_s_getreg((3 << 11) | 20) & 0xFu; }
#define XB_SPIN(cond, bar) do { unsigned _sp = 0; while (cond) { __builtin_amdgcn_s_sleep(1); \
    if ((++_sp & 255u) == 0u) { if (xb_ld(&(bar)[XB_TMO])) break; if (_sp > XB_SPIN_CAP) { atomicAdd(&(bar)[XB_TMO], 1u); break; } } } } while (0)
struct XcdBarrier { unsigned* bar; unsigned x; volatile LAS unsigned* st; };
DI XcdBarrier xcd_barrier_post(unsigned* bar, volatile LAS unsigned* st) {
  XcdBarrier b; b.bar = bar; b.x = xb_xcc_id(); b.st = st;
  if (threadIdx.x == 0) (void)xb_add(&bar[XB_XCNT(b.x)], 1u);
  return b;
}
DI void xcd_barrier_complete(unsigned* bar, unsigned x, unsigned& nloc, unsigned& nx, unsigned G) {
  unsigned sum, cnt, mine, sp = 0u;
  for (;;) {
    sum = 0u; cnt = 0u; mine = 0u;
#pragma unroll
    for (unsigned j = 0; j < 16; ++j) { const unsigned c = xb_ld(&bar[XB_XCNT(j)]); sum += c; cnt += (c > 0u) ? 1u : 0u; mine = (j == x) ? c : mine; }
    if (sum == G) break;
    __builtin_amdgcn_s_sleep(1);
    if ((++sp & 255u) == 0u) { if (xb_ld(&bar[XB_TMO])) break; if (sp > XB_SPIN_CAP) { atomicAdd(&bar[XB_TMO], 1u); break; } }
  }
  nloc = mine > 0u ? mine : 1u; nx = cnt > 0u ? cnt : 1u;
}
DI void xcd_barrier(unsigned* bar_, volatile LAS unsigned* st_, unsigned G) {
  XcdBarrier b; b.bar = bar_; b.x = xb_xcc_id(); b.st = st_;
  asm volatile("s_waitcnt vmcnt(0)" ::: "memory");
  __syncthreads();
  if (threadIdx.x == 0) {
    unsigned* bar = b.bar;
    __builtin_amdgcn_s_waitcnt(0);
    unsigned nloc = b.st[0], nx = b.st[1];
    if (nloc == 0u) { xcd_barrier_complete(bar, b.x, nloc, nx, G); b.st[0] = nloc; b.st[1] = nx; }
    const unsigned old = xb_add(&bar[XB_XSUB(b.x)], 1u);
    const unsigned gen = old / nloc;
    if (old + 1u == (gen + 1u) * nloc) {
      __builtin_amdgcn_fence(__ATOMIC_RELEASE, "agent");
      asm volatile("s_waitcnt vmcnt(0)" ::: "memory");
      const unsigned og = xb_add(&bar[XB_TOP], 1u);
      const unsigned tg = og / nx;
      if (og + 1u == (tg + 1u) * nx) xb_add(&bar[XB_TOPGEN], 1u);
      else XB_SPIN(xb_ld(&bar[XB_TOPGEN]) == tg, bar);
      __builtin_amdgcn_fence(__ATOMIC_ACQUIRE, "agent");
      xb_add(&bar[XB_XGEN(b.x)], 1u);
      asm volatile("s_waitcnt vmcnt(0)" ::: "memory");
    } else {
      XB_SPIN(xb_ld(&bar[XB_XGEN(b.x)]) == gen, bar);
      __builtin_amdgcn_fence(__ATOMIC_ACQUIRE, "agent");
      asm volatile("s_waitcnt vmcnt(0)" ::: "memory");
    }
  }
  __syncthreads();
}

constexpr int SMEM_BYTES = 78848;
static_assert(SMEM_BYTES >= 4 * 1024 * 4, "peer smem");
static_assert(SMEM_BYTES >= 2 * 2 * 128 * GSTR * 2, "gemm smem");
static_assert(SMEM_BYTES >= (128 * KSTR + 64 * VSTR) * 2, "attn smem");

__global__ void __launch_bounds__(NTHR, 2) fwd_megakernel(Params p) {
  __shared__ __attribute__((aligned(16))) char smem[SMEM_BYTES];
  __shared__ uint4 xb_words, xg_words;
  cg::grid_group grid = cg::this_grid();
  if (threadIdx.x == 0) { xb_words = make_uint4(0u, 0u, 0u, 0u); xg_words = make_uint4(0u, 0u, 0u, 0u); }
  __syncthreads();
  const Grp gr = my_grp();
  unsigned* gbar = (unsigned*)(p.ws + OFF_BAR);
  unsigned* mbar = (unsigned*)(p.ws + OFF_BAR + (size_t)(1 + gr.g) * 16384);
  unsigned* flag = (unsigned*)(p.ws + OFF_BAR + 3 * 16384);
  (void)xcd_barrier_post(gbar, (volatile LAS unsigned*)&xb_words);
  (void)xcd_barrier_post(mbar, (volatile LAS unsigned*)&xg_words);
  if (p.ws == nullptr) grid.sync();
#define GBARRIER() xcd_barrier(gbar, (volatile LAS unsigned*)&xb_words, gridDim.x)
#define MBARRIER() xcd_barrier(mbar, (volatile LAS unsigned*)&xg_words, (unsigned)gr.GB)
  phase0(p, smem);
  GBARRIER();
  const int nshard = 8;
  phase_modreduce(p);
  GBARRIER();
  phase_ln0(p);
  GBARRIER();
  if (SPLIT_OFFSET && gr.g == 1) {
    convert_tables(p, 3 * NEXP, 4 * NEXP, gr.lb * 4 + (int)(threadIdx.x >> 6), gr.GB * 4);
    __threadfence();
    __syncthreads();
    if (threadIdx.x == 0) atomicAdd(flag, 1u);
  }
  int* ctr = (int*)(p.ws + OFF_QCTR) + gr.g * (32 * 512);
  for (int l = 0; l < DEPTH; ++l) {
    gemm_phase(gr, nshard, (const bf16_t*)(p.ws + OFF_H), (const bf16_t*)(p.ws + OFF_WINT) + (size_t)l * PC * DM, PC, smem, ctr + ((l * 4 + 0) * 2) * 512, EpiG1{&p, l});
    MBARRIER();
    phase_mixers(gr, nshard, p, l, smem, ctr + ((l * 4 + 1) * 2) * 512);
    MBARRIER();
    gemm_phase(gr, nshard, (const bf16_t*)(p.ws + OFF_O), (const bf16_t*)(p.ws + OFF_WOUTT) + (size_t)l * DM * DM, DM, smem, ctr + ((l * 4 + 2) * 2) * 512, EpiG2{&p, l, false});
    MBARRIER();
    phase_ln1(gr, p, l, false);
    MBARRIER();
    gemm_phase(gr, nshard, (const bf16_t*)(p.ws + OFF_H), (const bf16_t*)(p.ws + OFF_WQT) + (size_t)l * DM * DM, DM, smem, ctr + ((l * 4 + 3) * 2) * 512, EpiG3{&p});
    if (SPLIT_OFFSET && l == 3 && gr.g == 0) {
      if (threadIdx.x == 0) { XB_SPIN(xb_ld(flag) < (unsigned)gr.GB, gbar); }
      __syncthreads();
    }
    MBARRIER();
    phase_peer(gr, p, l, smem, false);
    if (l + 1 < DEPTH) MBARRIER();
  }
}

extern "C" void kernel_launch(void* const* d_in, const int* in_sizes, int n_in, void* d_out, int out_size, void* d_ws,
                              size_t ws_size, hipStream_t stream) {
  static int grid_blocks = 0;
  if (!grid_blocks) {
    int dev = 0, cus = 0, per_cu = 0;
    (void)hipGetDevice(&dev);
    (void)hipDeviceGetAttribute(&cus, hipDeviceAttributeMultiprocessorCount, dev);
    (void)hipOccupancyMaxActiveBlocksPerMultiprocessor(&per_cu, fwd_megakernel, NTHR, 0);
    if (per_cu > 2) per_cu = 2;
    if (per_cu < 1) per_cu = 1;
    grid_blocks = cus * per_cu;
  }
  Params p{};
  const float** pp = (const float**)&p;
  for (int i = 0; i < 26; ++i) pp[i] = (const float*)d_in[i];
  p.out = (float*)d_out;
  p.ws = (char*)d_ws;
  void* args[] = {&p};
  (void)hipMemsetAsync((char*)d_ws + OFF_BAR, 0, 4 * 16384, stream);
  hipError_t e = hipLaunchCooperativeKernel((void*)fwd_megakernel, dim3(grid_blocks), dim3(NTHR), args, 0, stream);
  if (e != hipSuccess) fprintf(stderr, "cooperative launch failed: %s (grid %d)\n", hipGetErrorString(e), grid_blocks);
}
```
